# Optimizing an MI355X kernel written in HIP

```python
import jax
import jax.numpy as jnp
from jax import lax
import numpy as np


D_MODEL = 2048
BATCH = 4
SEQ = 4096
DEPTH = 4

A_WIDTH = D_MODEL // 2
B_WIDTH = D_MODEL - A_WIDTH
A_GROUPS = 8
A_GROUP_DIM = A_WIDTH // A_GROUPS
CHUNK = 128
CONV_WIDTH = 3
ATTN_HEAD_DIM = 128
ATTN_HEADS = D_MODEL // ATTN_HEAD_DIM
DILATED_BRANCHES = ((128, 1), (512, 4), (2048, 16))
ATTN_BLOCK = 128
ROPE_THETA = 10000.0
FFN_DIM = 4 * D_MODEL
N_EVEN = (DEPTH + 1) // 2
N_ODD = DEPTH // 2
RMS_EPS = 1e-6
LN_EPS = 1e-5

kernel_name = 'hybrid_gmlp_shortconv_dilated_attn_trunk'


def rmsnorm(x, g):
    xf = x.astype(jnp.float32)
    y = xf * lax.rsqrt(jnp.mean(xf * xf, axis=-1, keepdims=True) + RMS_EPS)
    return (y * g.astype(jnp.float32)).astype(x.dtype)


def rope(t, positions):
    dh = t.shape[-1]
    half = dh // 2
    inv_freq = ROPE_THETA ** (-jnp.arange(half, dtype=jnp.float32) * 2.0 / dh)
    ang = positions.astype(jnp.float32)[:, None] * inv_freq[None, :]
    cos = jnp.cos(ang)[None, :, None, :]
    sin = jnp.sin(ang)[None, :, None, :]
    t1 = t[..., :half].astype(jnp.float32)
    t2 = t[..., half:].astype(jnp.float32)
    out = jnp.concatenate([t1 * cos - t2 * sin, t2 * cos + t1 * sin], axis=-1)
    return out.astype(t.dtype)


def gmlp_shortconv_mixer(h, w_in, w_s, b_s, conv_w, w_out):
    bsz, s, _ = h.shape
    proj = h @ w_in
    a_u, a_v, g_b, g_c, b_x = jnp.split(
        proj, [A_WIDTH, 2 * A_WIDTH, 2 * A_WIDTH + B_WIDTH, 2 * A_WIDTH + 2 * B_WIDTH], axis=-1)

    a_u = jax.nn.gelu(a_u)
    a_v = jax.nn.gelu(a_v)
    vf = a_v.astype(jnp.float32)
    mu = jnp.mean(vf, axis=-1, keepdims=True)
    var = jnp.mean(jnp.square(vf - mu), axis=-1, keepdims=True)
    vn = ((vf - mu) * lax.rsqrt(var + LN_EPS)).astype(h.dtype)
    n_chunks = s // CHUNK
    vn = vn.reshape(bsz, n_chunks, CHUNK, A_GROUPS, A_GROUP_DIM)
    causal = jnp.tril(jnp.ones((CHUNK, CHUNK), dtype=bool))
    w_causal = jnp.where(causal[None], w_s, 0)
    mixed = jnp.einsum('gts,bnsgc->bntgc', w_causal, vn) + b_s.T[None, None, :, :, None]
    a_out = a_u * mixed.reshape(bsz, s, A_WIDTH)

    z = g_c * b_x
    zp = jnp.pad(z, ((0, 0), (CONV_WIDTH - 1, 0), (0, 0)))
    y = conv_w[0] * zp[:, 0:s]
    for tap in range(1, CONV_WIDTH):
        y = y + conv_w[tap] * zp[:, tap:tap + s]
    b_out = g_b * y

    return jnp.concatenate([a_out, b_out], axis=-1) @ w_out


def dilated_branch(q, k, v, window, dilation):
    bsz, s, nh, dh = q.shape
    n_steps = window // dilation
    blk = ATTN_BLOCK
    L = s // dilation
    nb = -(-L // blk)
    Lp = nb * blk

    def to_blocks(t):
        t = t.reshape(bsz, L, dilation, nh, dh).transpose(0, 2, 3, 1, 4)
        t = jnp.pad(t, ((0, 0), (0, 0), (0, 0), (0, Lp - L), (0, 0)))
        return t.reshape(bsz, dilation, nh, nb, blk, dh)

    def with_prev_block(t):
        prev = jnp.pad(t, ((0, 0), (0, 0), (0, 0), (1, 0), (0, 0), (0, 0)))[:, :, :, :-1]
        return jnp.concatenate([prev, t], axis=4)

    qb = to_blocks(q)
    kk = with_prev_block(to_blocks(k))
    vv = with_prev_block(to_blocks(v))

    scores = jnp.einsum('brhnqc,brhnkc->brhnqk', qb, kk).astype(jnp.float32) * (dh ** -0.5)
    qi = jnp.arange(blk)[:, None]
    ki = jnp.arange(2 * blk)[None, :]
    step = qi + blk - ki
    band = (step >= 0) & (step <= n_steps)
    key_idx = jnp.arange(nb)[:, None, None] * blk - blk + ki[None]
    mask = band[None] & (key_idx >= 0)
    scores = jnp.where(mask, scores, -jnp.inf)
    m = jnp.max(scores, axis=-1, keepdims=True)
    p = jnp.exp(scores - m)
    denom = jnp.sum(p, axis=-1, keepdims=True)
    o = jnp.einsum('brhnqk,brhnkc->brhnqc', (p / denom).astype(v.dtype), vv)
    lse = (m + jnp.log(denom))[..., 0]

    o = o.reshape(bsz, dilation, nh, Lp, dh)[:, :, :, :L].transpose(0, 3, 1, 2, 4).reshape(bsz, s, nh, dh)
    lse = lse.reshape(bsz, dilation, nh, Lp)[..., :L].transpose(0, 3, 1, 2).reshape(bsz, s, nh)
    return o, lse


def dilated_attention_mixer(h, w_qkv, w_o, positions):
    bsz, s, _ = h.shape
    qkv = h @ w_qkv
    q, k, v = jnp.split(qkv, 3, axis=-1)
    q = rope(q.reshape(bsz, s, ATTN_HEADS, ATTN_HEAD_DIM), positions)
    k = rope(k.reshape(bsz, s, ATTN_HEADS, ATTN_HEAD_DIM), positions)
    v = v.reshape(bsz, s, ATTN_HEADS, ATTN_HEAD_DIM)
    outs = []
    lses = []
    for window, dilation in DILATED_BRANCHES:
        o_i, lse_i = dilated_branch(q, k, v, window, dilation)
        outs.append(o_i.astype(jnp.float32))
        lses.append(lse_i)
    alpha = jax.nn.softmax(jnp.stack(lses, axis=0), axis=0)
    o = jnp.einsum('ibsh,ibshc->bshc', alpha, jnp.stack(outs, axis=0))
    return o.astype(h.dtype).reshape(bsz, s, ATTN_HEADS * ATTN_HEAD_DIM) @ w_o


def squared_relu_mlp(h, w_up, w_down):
    return jnp.square(jax.nn.relu(h @ w_up)) @ w_down


def setup_inputs(seed: int = 0) -> dict:
    key = jax.random.key(seed)
    ks = jax.random.split(key, 14)
    f32 = jnp.float32
    d = D_MODEL
    x = jax.random.normal(ks[0], (BATCH, SEQ, d), f32)
    norm_mix_pre = 1.0 + 0.05 * jax.random.normal(ks[1], (DEPTH, d), f32)
    norm_mix_post = 1.0 + 0.05 * jax.random.normal(ks[2], (DEPTH, d), f32)
    norm_mlp_pre = 1.0 + 0.05 * jax.random.normal(ks[3], (DEPTH, d), f32)
    norm_mlp_post = 1.0 + 0.05 * jax.random.normal(ks[4], (DEPTH, d), f32)
    in_cols = 2 * A_WIDTH + 3 * B_WIDTH
    w_in_ab = jax.random.normal(ks[5], (N_EVEN, d, in_cols), f32) * d ** -0.5
    w_spatial = jax.random.normal(ks[6], (N_EVEN, A_GROUPS, CHUNK, CHUNK), f32) * (0.5 * CHUNK ** -0.5)
    b_spatial = 1.0 + 0.1 * jax.random.normal(ks[7], (N_EVEN, A_GROUPS, CHUNK), f32)
    conv_w = jax.random.normal(ks[8], (N_EVEN, CONV_WIDTH, B_WIDTH), f32) * CONV_WIDTH ** -0.5
    w_out_ab = jax.random.normal(ks[9], (N_EVEN, A_WIDTH + B_WIDTH, d), f32) * (A_WIDTH + B_WIDTH) ** -0.5
    attn_width = ATTN_HEADS * ATTN_HEAD_DIM
    w_qkv = jax.random.normal(ks[10], (N_ODD, d, 3 * attn_width), f32) * d ** -0.5
    w_o = jax.random.normal(ks[11], (N_ODD, attn_width, d), f32) * attn_width ** -0.5
    w_up = jax.random.normal(ks[12], (DEPTH, d, FFN_DIM), f32) * d ** -0.5
    w_down = jax.random.normal(ks[13], (DEPTH, FFN_DIM, d), f32) * FFN_DIM ** -0.5
    return {'x': x, 'norm_mix_pre': norm_mix_pre, 'norm_mix_post': norm_mix_post,
            'norm_mlp_pre': norm_mlp_pre, 'norm_mlp_post': norm_mlp_post,
            'w_in_ab': w_in_ab, 'w_spatial': w_spatial, 'b_spatial': b_spatial,
            'conv_w': conv_w, 'w_out_ab': w_out_ab, 'w_qkv': w_qkv, 'w_o': w_o,
            'w_up': w_up, 'w_down': w_down}


def reference(x, norm_mix_pre, norm_mix_post, norm_mlp_pre, norm_mlp_post,
              w_in_ab, w_spatial, b_spatial, conv_w, w_out_ab, w_qkv, w_o,
              w_up, w_down):
    positions = jnp.arange(x.shape[1], dtype=jnp.int32)
    h = x
    for layer in range(DEPTH):
        hn = rmsnorm(h, norm_mix_pre[layer])
        if layer % 2 == 0:
            e = layer // 2
            mix = gmlp_shortconv_mixer(hn, w_in_ab[e], w_spatial[e], b_spatial[e], conv_w[e], w_out_ab[e])
        else:
            o = layer // 2
            mix = dilated_attention_mixer(hn, w_qkv[o], w_o[o], positions)
        h = h + rmsnorm(mix, norm_mix_post[layer])
        f = squared_relu_mlp(rmsnorm(h, norm_mlp_pre[layer]), w_up[layer], w_down[layer])
        h = h + rmsnorm(f, norm_mlp_post[layer])
    return h
```

```cpp
#include <hip/hip_runtime.h>
#include <hip/hip_cooperative_groups.h>
#include <cstdio>
#include <cstdint>
namespace cg = cooperative_groups;

#define PG8_LAS __attribute__((address_space(3)))
#define LAS __attribute__((address_space(3)))
typedef unsigned short bf16_t;
typedef short bf16x8 __attribute__((ext_vector_type(8)));
typedef short s16x4 __attribute__((ext_vector_type(4)));
typedef float f32x4 __attribute__((ext_vector_type(4)));
typedef float f32x2 __attribute__((ext_vector_type(2)));
typedef unsigned u32x4 __attribute__((ext_vector_type(4)));
typedef unsigned u32x2 __attribute__((ext_vector_type(2)));

constexpr int T_TOK = 16384, DM = 2048, SEQ = 4096;

__device__ __forceinline__ unsigned cvt_pk_bf16(float lo, float hi) { unsigned r; asm volatile("v_cvt_pk_bf16_f32 %0, %1, %2" : "=v"(r) : "v"(lo), "v"(hi)); return r; }
__device__ __forceinline__ float bf_lo(unsigned w) { return __uint_as_float(w << 16); }
__device__ __forceinline__ float bf_hi(unsigned w) { return __uint_as_float(w & 0xffff0000u); }
__device__ __forceinline__ float gelu_tanh(float x) {
    const float u = 0.7978845608028654f * (x + 0.044715f * x * x * x);
    const float e = __builtin_amdgcn_exp2f(-2.885390081777927f * u);
    return x * __builtin_amdgcn_rcpf(1.0f + e);
}

namespace pg8 {
constexpr int BM = 256, BK = 64, HALF = 128, HTB = HALF * BK * 2  , STAGE_BYTES = 8 * HTB, NXCD = 8, WGM = 8;

__host__ __device__ __forceinline__ int lds_byte(int r, int c) { const int st = (r >> 4) * 2 + (c >> 5), rr = r & 15, cc = c & 31, ob = rr * 64 + cc * 2; return st * 1024 + (ob ^ (((ob >> 9) & 1) << 5)); }
__host__ __device__ __forceinline__ void stage_rc(int b, int& R, int& C) { const int st = b / 1024, sb = b % 1024, swz = sb ^ (((sb >> 9) & 1) << 5); R = (st >> 1) * 16 + swz / 64; C = (st & 1) * 32 + (swz % 64) / 2; }
__host__ __device__ __forceinline__ int perm32(int rho) { const int n = rho >> 4, i = rho & 15; return 8 * (i >> 2) + 4 * n + (i & 3); }

struct Unit { int pm, pn; };
struct Gemm { const bf16_t* A; const bf16_t* Bt; int M, N, K; };

struct StaticOrder {
    int nM, nN, nwg, G, c;
    __host__ __device__ void init(int M, int N, int G_, int c_) { nM = M / BM; nN = N / BM; nwg = nM * nN; G = G_; c = c_; }
    __host__ __device__ bool next(int i, Unit& u) const {
        const long L = (long)i * G + c; if (L >= nwg) return false;
        int wgid = (int)L; { const int q = nwg / NXCD, r = nwg % NXCD, xcd = wgid % NXCD, off = wgid / NXCD; wgid = (xcd < r ? xcd * (q + 1) : r * (q + 1) + (xcd - r) * q) + off; }
        const int nig = WGM * nN, gid = wgid / nig, fm = gid * WGM, gsz = (nM - fm) < WGM ? (nM - fm) : WGM;
        u.pm = fm + ((wgid % nig) % gsz); u.pn = (wgid % nig) / gsz; return true;
    }
    __device__ __forceinline__ void a_ready(const Unit&) const {}
    __device__ __forceinline__ void done(const Unit&) const {}
};
struct EpiF32 {
    static constexpr bool PERM = false, AFTER_DRAIN = false;
    float* C; int ldc;
    __device__ __forceinline__ void operator()(const f32x4 (&acc)[2][2][4][2], const Unit& u, int wr, int wc, int fr, int fq) const {
        const int row0 = u.pm * BM + wr * 64 + fr, col0 = u.pn * BM + wc * 32 + 4 * fq;
#pragma unroll
        for (int ai = 0; ai < 2; ++ai)
#pragma unroll
            for (int m = 0; m < 4; ++m) { float* rowp = C + (size_t)(row0 + ai * HALF + m * 16) * ldc + col0;
#pragma unroll
                for (int bj = 0; bj < 2; ++bj)
#pragma unroll
                    for (int n = 0; n < 2; ++n) *(f32x4*)(rowp + bj * HALF + n * 16) = acc[ai][bj][m][n]; }
    }
};
struct EpiProj {
    static constexpr bool PERM = true, AFTER_DRAIN = false;
    bf16_t* O; float* stats;
    __device__ __forceinline__ void operator()(const f32x4 (&acc)[2][2][4][2], const Unit& u, int wr, int wc, int fr, int fq) const {
        const int row0 = u.pm * BM + wr * 64 + fr, col0 = u.pn * BM + wc * 32 + 8 * fq;
        const bool act = u.pn < 8, st = (u.pn >= 4) && (u.pn < 8);
#pragma unroll
        for (int ai = 0; ai < 2; ++ai)
#pragma unroll
            for (int m = 0; m < 4; ++m) { const int row = row0 + ai * HALF + m * 16; bf16_t* rowp = O + (size_t)row * 5120 + col0; float s = 0.f, ss = 0.f;
#pragma unroll
                for (int bj = 0; bj < 2; ++bj) { f32x4 v0 = acc[ai][bj][m][0], v1 = acc[ai][bj][m][1];
                    if (act) {
#pragma unroll
                        for (int j = 0; j < 4; ++j) { v0[j] = gelu_tanh(v0[j]); v1[j] = gelu_tanh(v1[j]); }
                    }
                    u32x4 w; w.x = cvt_pk_bf16(v0[0], v0[1]); w.y = cvt_pk_bf16(v0[2], v0[3]); w.z = cvt_pk_bf16(v1[0], v1[1]); w.w = cvt_pk_bf16(v1[2], v1[3]);
                    if (st) {
                        const float a0 = bf_lo(w.x), a1 = bf_hi(w.x), a2 = bf_lo(w.y), a3 = bf_hi(w.y), a4 = bf_lo(w.z), a5 = bf_hi(w.z), a6 = bf_lo(w.w), a7 = bf_hi(w.w);
                        s += ((a0 + a1) + (a2 + a3)) + ((a4 + a5) + (a6 + a7));
                        ss += ((a0 * a0 + a1 * a1) + (a2 * a2 + a3 * a3)) + ((a4 * a4 + a5 * a5) + (a6 * a6 + a7 * a7)); }
                    *(u32x4*)(rowp + bj * HALF) = w; }
                if (st) { s += __shfl_xor(s, 16); s += __shfl_xor(s, 32); ss += __shfl_xor(ss, 16); ss += __shfl_xor(ss, 32);
                    if (fq == 0) *(f32x2*)(stats + ((size_t)row * 16 + (u.pn - 4) * 4 + wc) * 2) = (f32x2){s, ss}; } }
    }
};
struct EpiRelu2 {
    static constexpr bool PERM = true, AFTER_DRAIN = false;
    bf16_t* O; int ldc;
    __device__ __forceinline__ void operator()(const f32x4 (&acc)[2][2][4][2], const Unit& u, int wr, int wc, int fr, int fq) const {
        const int row0 = u.pm * BM + wr * 64 + fr, col0 = u.pn * BM + wc * 32 + 8 * fq;
#pragma unroll
        for (int ai = 0; ai < 2; ++ai)
#pragma unroll
            for (int m = 0; m < 4; ++m) { bf16_t* rowp = O + (size_t)(row0 + ai * HALF + m * 16) * ldc + col0;
#pragma unroll
                for (int bj = 0; bj < 2; ++bj) { f32x4 v0 = acc[ai][bj][m][0], v1 = acc[ai][bj][m][1];
#pragma unroll
                    for (int j = 0; j < 4; ++j) { const float a = fmaxf(v0[j], 0.f), b = fmaxf(v1[j], 0.f); v0[j] = a * a; v1[j] = b * b; }
                    u32x4 w; w.x = cvt_pk_bf16(v0[0], v0[1]); w.y = cvt_pk_bf16(v0[2], v0[3]); w.z = cvt_pk_bf16(v1[0], v1[1]); w.w = cvt_pk_bf16(v1[2], v1[3]);
                    *(u32x4*)(rowp + bj * HALF) = w; } }
    }
};
struct EpiQKV {
    static constexpr bool PERM = true, AFTER_DRAIN = false;
    bf16_t* O; const float* cosT; const float* sinT;
    __device__ __forceinline__ void operator()(const f32x4 (&acc)[2][2][4][2], const Unit& u, int wr, int wc, int fr, int fq) const {
        const int row0 = u.pm * BM + wr * 64 + fr, dlo = (wc & 1) * 32 + 8 * fq, col0 = u.pn * BM + (wc >> 1) * 128 + dlo;
        const bool rot = u.pn < 16; const float qs = (u.pn < 8) ? (0.08838834764831845f * 1.4426950408889634f) : 1.0f;
#pragma unroll
        for (int ai = 0; ai < 2; ++ai)
#pragma unroll
            for (int m = 0; m < 4; ++m) { const int row = row0 + ai * HALF + m * 16; bf16_t* rowp = O + (size_t)row * 6144 + col0;
                f32x4 x1a = acc[ai][0][m][0], x1b = acc[ai][0][m][1], x2a = acc[ai][1][m][0], x2b = acc[ai][1][m][1];
                if (rot) { const int pos = row & (SEQ - 1); const float* cp = cosT + pos * 64 + dlo; const float* sp = sinT + pos * 64 + dlo;
                    const f32x4 ca = *(const f32x4*)cp, cb = *(const f32x4*)(cp + 4), sa = *(const f32x4*)sp, sb = *(const f32x4*)(sp + 4);
                    const f32x4 o1a = (x1a * ca - x2a * sa) * qs, o1b = (x1b * cb - x2b * sb) * qs, o2a = (x2a * ca + x1a * sa) * qs, o2b = (x2b * cb + x1b * sb) * qs;
                    x1a = o1a; x1b = o1b; x2a = o2a; x2b = o2b; }
                u32x4 w1, w2; w1.x = cvt_pk_bf16(x1a[0], x1a[1]); w1.y = cvt_pk_bf16(x1a[2], x1a[3]); w1.z = cvt_pk_bf16(x1b[0], x1b[1]); w1.w = cvt_pk_bf16(x1b[2], x1b[3]);
                w2.x = cvt_pk_bf16(x2a[0], x2a[1]); w2.y = cvt_pk_bf16(x2a[2], x2a[3]); w2.z = cvt_pk_bf16(x2b[0], x2b[1]); w2.w = cvt_pk_bf16(x2b[2], x2b[3]);
                *(u32x4*)rowp = w1; *(u32x4*)(rowp + 64) = w2; }
    }
};

template <class Epi, class Sched, bool STAMP = false>
__device__ __forceinline__ void gemm_phase(PG8_LAS unsigned char* lds, const Gemm g, const Sched& S, const Epi& E, unsigned long long* stamps) {
    int tid = threadIdx.x; asm volatile("" : "+v"(tid));
    const int wid = __builtin_amdgcn_readfirstlane(tid >> 6), lane = tid & 63, wr = wid >> 2, wc = wid & 3, fr = lane & 15, fq = lane >> 4;
    const int K = g.K, nt = K / BK;
    int ts_lo = 0, ts_hi = 0, nts = 0; const unsigned long long rt_entry = STAMP ? (unsigned long long)wall_clock64() : 0ull;
#define PG8_STAMP() do { if (STAMP && wid == 0 && nts < 64) { const unsigned long long _c = (unsigned long long)clock64(); \
        ts_lo = (lane == nts) ? (int)(unsigned)_c : ts_lo; ts_hi = (lane == nts) ? (int)(unsigned)(_c >> 32) : ts_hi; ++nts; } } while (0)
    PG8_STAMP();
    unsigned voffA[2], voffB[2];
#pragma unroll
    for (int i = 0; i < 2; ++i) { int R, C; stage_rc(tid * 16 + i * 8192, R, C); const int Rb = Epi::PERM ? ((R & ~31) + perm32(R & 31)) : R;
        voffA[i] = (unsigned)(R * K + C) * 2u; voffB[i] = (unsigned)(Rb * K + C) * 2u; }
    const size_t kstep = (size_t)(BK * 2);
    const size_t hstep = (size_t)HALF * K * 2;
    const size_t tstep = 2 * hstep;
    const unsigned ldsw = (unsigned)wid * 1024u;
    const int aoff = lds_byte(wr * 64 + fr, fq * 8), boff = lds_byte(wc * 32 + fr, fq * 8);
#define PG8_SA(b, h) (((b) * 2 + (h)) * HTB)
#define PG8_SB(b, h) ((4 + (b) * 2 + (h)) * HTB)
#define PG8_STAGE(bufoff, gbase, voff) do { _Pragma("unroll") for (int _i = 0; _i < 2; ++_i) \
        __builtin_amdgcn_global_load_lds((const unsigned*)((const char*)(gbase) + (voff)[_i]), (PG8_LAS unsigned*)(lds + (bufoff) + ldsw + _i * 8192), 16, 0, 0); } while (0)
#define PG8_LDA(dst, b, h) do { _Pragma("unroll") for (int m = 0; m < 4; ++m) _Pragma("unroll") for (int k = 0; k < 2; ++k) dst[m][k] = *(const PG8_LAS bf16x8*)(lds + PG8_SA(b, h) + aoff + m * 2048 + k * 1024); } while (0)
#define PG8_LDB(dst, b, h) do { _Pragma("unroll") for (int n = 0; n < 2; ++n) _Pragma("unroll") for (int k = 0; k < 2; ++k) dst[n][k] = *(const PG8_LAS bf16x8*)(lds + PG8_SB(b, h) + boff + n * 2048 + k * 1024); } while (0)
#define PG8_MMA(ai, bj, At, Bt) do { __builtin_amdgcn_s_setprio(1); _Pragma("unroll") for (int m = 0; m < 4; ++m) _Pragma("unroll") for (int n = 0; n < 2; ++n) _Pragma("unroll") for (int k = 0; k < 2; ++k) \
        acc[ai][bj][m][n] = __builtin_amdgcn_mfma_f32_16x16x32_bf16(Bt[n][k], At[m][k], acc[ai][bj][m][n], 0, 0, 0); __builtin_amdgcn_s_setprio(0); } while (0)
#define PG8_WAIT_V(n) asm volatile("s_waitcnt vmcnt(" #n ")" ::: "memory")
#define PG8_WAIT_L(n) asm volatile("s_waitcnt lgkmcnt(" #n ")" ::: "memory")
#define PG8_BAR __builtin_amdgcn_s_barrier()
#define PG8_SCHED __builtin_amdgcn_sched_barrier(0)
    Unit cur, nxt; int ui = 0;
    if (!S.next(0, cur)) return;
    f32x4 acc[2][2][4][2];
#pragma unroll
    for (int a = 0; a < 2; ++a)
#pragma unroll
        for (int b = 0; b < 2; ++b)
#pragma unroll
            for (int m = 0; m < 4; ++m)
#pragma unroll
                for (int n = 0; n < 2; ++n) acc[a][b][m][n] = (f32x4){0.f, 0.f, 0.f, 0.f};
    bf16x8 At[4][2], B0[2][2], B1[2][2];
    const char* cA = (const char*)g.A + (size_t)cur.pm * tstep; const char* cB = (const char*)g.Bt + (size_t)cur.pn * tstep;
    S.a_ready(cur);
    PG8_STAGE(PG8_SB(0, 0), cB, voffB); PG8_STAGE(PG8_SA(0, 0), cA, voffA); PG8_STAGE(PG8_SB(0, 1), cB + hstep, voffB); PG8_STAGE(PG8_SA(0, 1), cA + hstep, voffA);
    if (wr == 1) PG8_BAR;
    PG8_WAIT_V(4); PG8_BAR;
    PG8_STAGE(PG8_SB(1, 0), cB + kstep, voffB); PG8_STAGE(PG8_SA(1, 0), cA + kstep, voffA); PG8_STAGE(PG8_SB(1, 1), cB + hstep + kstep, voffB);
    PG8_WAIT_V(6); PG8_BAR;
    PG8_STAMP();
    for (;;) {
        const bool has_next = S.next(ui + 1, nxt);
        const char* nA = has_next ? (const char*)g.A + (size_t)nxt.pm * tstep : cA; const char* nB = has_next ? (const char*)g.Bt + (size_t)nxt.pn * tstep : cB;
        for (int t = 0; t < nt; t += 2) {
            const bool last = (t == nt - 2);
            const char* a1 = cA + (size_t)(t + 1) * kstep;
            const char* a2 = last ? nA : cA + (size_t)(t + 2) * kstep; const char* b2 = last ? nB : cB + (size_t)(t + 2) * kstep;
            const char* a3 = a2 + kstep; const char* b3 = b2 + kstep;
            if (last && has_next) S.a_ready(nxt);
            PG8_LDB(B0, 0, 0); PG8_SCHED; PG8_LDA(At, 0, 0); PG8_STAGE(PG8_SA(1, 1), a1 + hstep, voffA);
            PG8_WAIT_L(8); PG8_BAR; PG8_WAIT_L(0); PG8_MMA(0, 0, At, B0); PG8_BAR; PG8_SCHED;
            PG8_LDB(B1, 0, 1); PG8_STAGE(PG8_SB(0, 0), b2, voffB);
            PG8_BAR; PG8_WAIT_L(0); PG8_MMA(0, 1, At, B1); PG8_BAR;
            PG8_LDA(At, 0, 1); PG8_STAGE(PG8_SA(0, 0), a2, voffA);
            PG8_BAR; PG8_WAIT_L(0); PG8_MMA(1, 0, At, B0); PG8_BAR; PG8_SCHED;
            PG8_STAGE(PG8_SB(0, 1), b2 + hstep, voffB);
            PG8_WAIT_V(6); PG8_BAR; PG8_MMA(1, 1, At, B1); PG8_BAR;
            PG8_LDB(B0, 1, 0); PG8_SCHED; PG8_LDA(At, 1, 0); PG8_STAGE(PG8_SA(0, 1), a2 + hstep, voffA);
            PG8_WAIT_L(8); PG8_BAR; PG8_WAIT_L(0); PG8_MMA(0, 0, At, B0); PG8_BAR; PG8_SCHED;
            PG8_LDB(B1, 1, 1); PG8_STAGE(PG8_SB(1, 0), b3, voffB);
            PG8_BAR; PG8_WAIT_L(0); PG8_MMA(0, 1, At, B1); PG8_BAR;
            PG8_LDA(At, 1, 1); PG8_STAGE(PG8_SA(1, 0), a3, voffA);
            PG8_BAR; PG8_WAIT_L(0); PG8_MMA(1, 0, At, B0); PG8_BAR; PG8_SCHED;
            PG8_STAGE(PG8_SB(1, 1), b3 + hstep, voffB);
            PG8_WAIT_V(6); PG8_BAR; PG8_MMA(1, 1, At, B1); PG8_BAR;
        }
        PG8_STAMP();
        if constexpr (!Epi::AFTER_DRAIN) { E(acc, cur, wr, wc, fr, fq); S.done(cur); }
        PG8_STAMP();
        if (!has_next) break;
#pragma unroll
        for (int a = 0; a < 2; ++a)
#pragma unroll
            for (int b = 0; b < 2; ++b)
#pragma unroll
                for (int m = 0; m < 4; ++m)
#pragma unroll
                    for (int n = 0; n < 2; ++n) acc[a][b][m][n] = (f32x4){0.f, 0.f, 0.f, 0.f};
        cur = nxt; cA = nA; cB = nB; ++ui;
    }
    PG8_WAIT_V(0);
    if (wr == 0) PG8_BAR;
    PG8_BAR;
    if constexpr (Epi::AFTER_DRAIN) { E.fused(acc, cur, wr, wc, fr, fq, lds, wid, lane); S.done(cur); }
    PG8_STAMP();
    if (STAMP && wid == 0) { stamps[lane] = lane < nts ? (((unsigned long long)(unsigned)ts_hi << 32) | (unsigned)ts_lo) : 0ull;
        if (lane == 62) stamps[62] = rt_entry; if (lane == 63) stamps[63] = (unsigned long long)wall_clock64(); }
#undef PG8_STAMP
#undef PG8_SA
#undef PG8_SB
#undef PG8_STAGE
#undef PG8_LDA
#undef PG8_LDB
#undef PG8_MMA
#undef PG8_WAIT_V
#undef PG8_WAIT_L
#undef PG8_BAR
#undef PG8_SCHED
}}

constexpr size_t SZ_WIN = (size_t)2 * 5120 * 2048 * 2, SZ_W22 = (size_t)2 * 2048 * 2048 * 2, SZ_WQKV = (size_t)2 * 6144 * 2048 * 2, SZ_WUP = (size_t)4 * 8192 * 2048 * 2;
constexpr size_t OFF_WIN = 0, OFF_WOUT = OFF_WIN + SZ_WIN, OFF_WQKV = OFF_WOUT + SZ_W22, OFF_WO = OFF_WQKV + SZ_WQKV, OFF_WUP = OFF_WO + SZ_W22, OFF_WDOWN = OFF_WUP + SZ_WUP;
constexpr size_t OFF_WSP = OFF_WDOWN + SZ_WUP;
constexpr size_t OFF_ROPE = OFF_WSP + (size_t)2 * 8 * 128 * 128 * 2;
constexpr size_t OFF_STATS = OFF_ROPE + (size_t)2 * 4096 * 64 * 4;
constexpr size_t OFF_LSE = OFF_STATS + (size_t)T_TOK * 16 * 8;
constexpr size_t OFF_HN = OFF_LSE + (size_t)3 * T_TOK * 16 * 4;
constexpr size_t OFF_GOUT = OFF_HN + (size_t)T_TOK * DM * 2;
constexpr size_t OFF_MO = OFF_GOUT + (size_t)T_TOK * DM * 4;
constexpr size_t OFF_BIG = OFF_MO + (size_t)T_TOK * DM * 2;
constexpr size_t WS_END = OFF_BIG + (size_t)T_TOK * 8192 * 2;
constexpr int LDS_BYTES = 143360;

struct Params {
    const float* x; const float* n_mix_pre; const float* n_mix_post; const float* n_mlp_pre; const float* n_mlp_post;
    const float* w_in; const float* w_sp; const float* b_sp; const float* conv_w; const float* w_out; const float* w_qkv; const float* w_o; const float* w_up; const float* w_down;
    float* out; unsigned char* ws;
};

__device__ __forceinline__ void transpose_cvt(LAS unsigned char* lds, const float* __restrict__ W, bf16_t* __restrict__ Wt, int L, int K, int N, int perm) {
    int tid = threadIdx.x; asm volatile("" : "+v"(tid));
    const int tk = K >> 7, tn = N >> 6, per = tk * tn, ntile = L * per;
    for (int t = blockIdx.x; t < ntile; t += gridDim.x) {
        const int l = t / per, r = t - l * per, kt = r / tn, nt = r - kt * tn;
        const float* src = W + ((size_t)l * K + (size_t)kt * 128) * N + nt * 64;
        __syncthreads();
#pragma unroll
        for (int i = 0; i < 2; ++i) { const int idx = tid + 512 * i, kp = idx >> 4, c4 = idx & 15;
            const f32x4 a = *(const f32x4*)(src + (size_t)(2 * kp) * N + 4 * c4), b = *(const f32x4*)(src + (size_t)(2 * kp + 1) * N + 4 * c4);
#pragma unroll
            for (int j = 0; j < 4; ++j) *(LAS unsigned*)(lds + (4 * c4 + j) * 272 + kp * 4) = cvt_pk_bf16(a[j], b[j]); }
        __syncthreads();
#pragma unroll
        for (int i = 0; i < 2; ++i) { const int idx = tid + 512 * i, n = idx >> 4, kc = idx & 15;
            const u32x4 v = *(const LAS u32x4*)(lds + n * 272 + kc * 16);
            int ncol = nt * 64 + n;
            if (perm) { const int nl = ncol & 255, hl = nl >> 7, dd = nl & 127; ncol = (ncol & ~255) + (dd >> 6) * 128 + hl * 64 + (dd & 63); }
            *(u32x4*)(Wt + ((size_t)l * N + ncol) * K + kt * 128 + kc * 8) = v; }
    }
}

__device__ __forceinline__ void norm_phase(const float* __restrict__ gin, const float* hin, float* hout, const float* __restrict__ gpost, const float* __restrict__ gpre, bf16_t* __restrict__ hn, int mode) {
    int tid = threadIdx.x; asm volatile("" : "+v"(tid));
    const int lane = tid & 63, w = tid >> 6;
    for (int row = blockIdx.x * 8 + w; row < T_TOK; row += gridDim.x * 8) {
        f32x4 hv[8];
        const float* hp = hin + (size_t)row * DM + 4 * lane;
#pragma unroll
        for (int i = 0; i < 8; ++i) hv[i] = *(const f32x4*)(hp + 256 * i);
        if (mode != 0) {
            f32x4 gv[8]; const float* gp = gin + (size_t)row * DM + 4 * lane; float ss = 0.f;
#pragma unroll
            for (int i = 0; i < 8; ++i) { gv[i] = *(const f32x4*)(gp + 256 * i); ss += (gv[i][0] * gv[i][0] + gv[i][1] * gv[i][1]) + (gv[i][2] * gv[i][2] + gv[i][3] * gv[i][3]); }
#pragma unroll
            for (int o = 1; o < 64; o <<= 1) ss += __shfl_xor(ss, o);
            const float r = 1.0f / sqrtf(ss * (1.0f / DM) + 1e-6f);
#pragma unroll
            for (int i = 0; i < 8; ++i) { const f32x4 g = *(const f32x4*)(gpost + 4 * lane + 256 * i); hv[i] = hv[i] + (gv[i] * r) * g; }
        }
        float* op = hout + (size_t)row * DM + 4 * lane;
#pragma unroll
        for (int i = 0; i < 8; ++i) *(f32x4*)(op + 256 * i) = hv[i];
        if (mode != 2) {
            float ss = 0.f;
#pragma unroll
            for (int i = 0; i < 8; ++i) ss += (hv[i][0] * hv[i][0] + hv[i][1] * hv[i][1]) + (hv[i][2] * hv[i][2] + hv[i][3] * hv[i][3]);
#pragma unroll
            for (int o = 1; o < 64; o <<= 1) ss += __shfl_xor(ss, o);
            const float r = 1.0f / sqrtf(ss * (1.0f / DM) + 1e-6f);
            bf16_t* np = hn + (size_t)row * DM + 4 * lane;
#pragma unroll
            for (int i = 0; i < 8; ++i) { const f32x4 g = *(const f32x4*)(gpre + 4 * lane + 256 * i); const f32x4 y = (hv[i] * r) * g;
                u32x2 wv; wv.x = cvt_pk_bf16(y[0], y[1]); wv.y = cvt_pk_bf16(y[2], y[3]); *(u32x2*)(np + 256 * i) = wv; }
        }
    }
}

__device__ __forceinline__ void tr8(unsigned alo, unsigned ahi, s16x4 (&lo)[4], s16x4 (&hi)[4]) {
    asm volatile("ds_read_b64_tr_b16 %0, %8\n\tds_read_b64_tr_b16 %1, %8 offset:32\n\tds_read_b64_tr_b16 %2, %8 offset:64\n\tds_read_b64_tr_b16 %3, %8 offset:96\n\t"
                 "ds_read_b64_tr_b16 %4, %9\n\tds_read_b64_tr_b16 %5, %9 offset:32\n\tds_read_b64_tr_b16 %6, %9 offset:64\n\tds_read_b64_tr_b16 %7, %9 offset:96\n\t"
                 "s_waitcnt lgkmcnt(0)"
                 : "=&v"(lo[0]), "=&v"(lo[1]), "=&v"(lo[2]), "=&v"(lo[3]), "=&v"(hi[0]), "=&v"(hi[1]), "=&v"(hi[2]), "=&v"(hi[3]) : "v"(alo), "v"(ahi) : "memory");
}
__device__ __forceinline__ bf16x8 cat4(s16x4 a, s16x4 b) { return (bf16x8){a[0], a[1], a[2], a[3], b[0], b[1], b[2], b[3]}; }
#define MFMA16(a, b, c) __builtin_amdgcn_mfma_f32_16x16x32_bf16((a), (b), (c), 0, 0, 0)

__device__ __forceinline__ void mixer_phase(LAS unsigned char* lds, unsigned ldsb, const bf16_t* __restrict__ proj, const float* __restrict__ stats, const bf16_t* __restrict__ Wc,
                                            const float* __restrict__ b_s, const float* __restrict__ conv_w, bf16_t* __restrict__ mo) {
    constexpr int VP = 288;
    int tid = threadIdx.x; asm volatile("" : "+v"(tid));
    const int w = __builtin_amdgcn_readfirstlane(tid >> 6), lane = tid & 63, j = lane & 15, fq = lane >> 4;
    LAS float* mu_s = (LAS float*)(lds + 128 * VP); LAS float* rs_s = mu_s + 128;
    for (int item = blockIdx.x; item < 1024; item += gridDim.x) {
        const int ch = item >> 3, g = item & 7, tok0 = ch * 128;
        __syncthreads();
        if (tid < 128) { const f32x2* sp = (const f32x2*)(stats + (size_t)(tok0 + tid) * 32); float s = 0.f, ss = 0.f;
#pragma unroll
            for (int i = 0; i < 16; ++i) { const f32x2 v = sp[i]; s += v.x; ss += v.y; }
            const float mu = s * (1.0f / 1024.0f), var = fmaxf(ss * (1.0f / 1024.0f) - mu * mu, 0.f);
            mu_s[tid] = mu; rs_s[tid] = 1.0f / sqrtf(var + 1e-5f); }
        __syncthreads();
#pragma unroll
        for (int i = 0; i < 4; ++i) { const int c = tid + 512 * i, row = c >> 4, ck = c & 15;
            const u32x4 raw = *(const u32x4*)(proj + (size_t)(tok0 + row) * 5120 + 1024 + g * 128 + ck * 8);
            const float mu = mu_s[row], rs = rs_s[row]; u32x4 o;
            o.x = cvt_pk_bf16((bf_lo(raw.x) - mu) * rs, (bf_hi(raw.x) - mu) * rs); o.y = cvt_pk_bf16((bf_lo(raw.y) - mu) * rs, (bf_hi(raw.y) - mu) * rs);
            o.z = cvt_pk_bf16((bf_lo(raw.z) - mu) * rs, (bf_hi(raw.z) - mu) * rs); o.w = cvt_pk_bf16((bf_lo(raw.w) - mu) * rs, (bf_hi(raw.w) - mu) * rs);
            *(LAS u32x4*)(lds + row * VP + ck * 16) = o; }
        __syncthreads();
        const int t = 16 * w + j;
        const bf16_t* wp = Wc + (size_t)(g * 128 + t) * 128 + 4 * fq;
        f32x4 acc[8];
#pragma unroll
        for (int i = 0; i < 8; ++i) acc[i] = (f32x4){0.f, 0.f, 0.f, 0.f};
        const unsigned abase = ldsb + (unsigned)((4 * fq + (j >> 2)) * VP + (j & 3) * 8);
#pragma unroll
        for (int ks = 0; ks < 4; ++ks) {
            if (ks <= (w >> 1)) {
                const s16x4 b0 = *(const s16x4*)(wp + 32 * ks), b1 = *(const s16x4*)(wp + 32 * ks + 16);
                const bf16x8 b = cat4(b0, b1);
                s16x4 lo[4], hi[4];
                const unsigned alo = abase + (unsigned)(32 * ks * VP), ahi = alo + 16 * VP;
                tr8(alo, ahi, lo, hi);
#pragma unroll
                for (int c = 0; c < 4; ++c) acc[c] = MFMA16(cat4(lo[c], hi[c]), b, acc[c]);
                tr8(alo + 128, ahi + 128, lo, hi);
#pragma unroll
                for (int c = 0; c < 4; ++c) acc[4 + c] = MFMA16(cat4(lo[c], hi[c]), b, acc[4 + c]);
            }
        }
        {
            const float bias = b_s[g * 128 + t];
            const bf16_t* up = proj + (size_t)(tok0 + t) * 5120 + g * 128 + 4 * fq;
            bf16_t* op = mo + (size_t)(tok0 + t) * DM + g * 128 + 4 * fq;
#pragma unroll
            for (int c = 0; c < 8; ++c) { const u32x2 au = *(const u32x2*)(up + 16 * c); u32x2 o;
                o.x = cvt_pk_bf16(bf_lo(au.x) * (acc[c][0] + bias), bf_hi(au.x) * (acc[c][1] + bias));
                o.y = cvt_pk_bf16(bf_lo(au.y) * (acc[c][2] + bias), bf_hi(au.y) * (acc[c][3] + bias));
                *(u32x2*)(op + 16 * c) = o; }
        }
#pragma unroll
        for (int i = 0; i < 4; ++i) { const int c = tid + 512 * i, row = c >> 4, ck = c & 15, cB = g * 128 + ck * 8, tok = tok0 + row, pos = tok & (SEQ - 1);
            const bf16_t* pp = proj + (size_t)tok * 5120 + cB;
            const u32x4 gb = *(const u32x4*)(pp + 2048);
            const u32x4 c0 = *(const u32x4*)(pp + 3072), x0 = *(const u32x4*)(pp + 4096);
            u32x4 c1 = (u32x4){0, 0, 0, 0}, x1 = c1, c2 = c1, x2 = c1;
            if (pos >= 1) { c1 = *(const u32x4*)(pp - 5120 + 3072); x1 = *(const u32x4*)(pp - 5120 + 4096); }
            if (pos >= 2) { c2 = *(const u32x4*)(pp - 10240 + 3072); x2 = *(const u32x4*)(pp - 10240 + 4096); }
            const f32x4 w0a = *(const f32x4*)(conv_w + cB), w0b = *(const f32x4*)(conv_w + cB + 4);
            const f32x4 w1a = *(const f32x4*)(conv_w + 1024 + cB), w1b = *(const f32x4*)(conv_w + 1024 + cB + 4);
            const f32x4 w2a = *(const f32x4*)(conv_w + 2048 + cB), w2b = *(const f32x4*)(conv_w + 2048 + cB + 4);
            const unsigned gbw[4] = {gb.x, gb.y, gb.z, gb.w}, c0w[4] = {c0.x, c0.y, c0.z, c0.w}, x0w[4] = {x0.x, x0.y, x0.z, x0.w}, c1w[4] = {c1.x, c1.y, c1.z, c1.w}, x1w[4] = {x1.x, x1.y, x1.z, x1.w},
                           c2w[4] = {c2.x, c2.y, c2.z, c2.w}, x2w[4] = {x2.x, x2.y, x2.z, x2.w};
            const float wt0[8] = {w0a[0], w0a[1], w0a[2], w0a[3], w0b[0], w0b[1], w0b[2], w0b[3]}, wt1[8] = {w1a[0], w1a[1], w1a[2], w1a[3], w1b[0], w1b[1], w1b[2], w1b[3]},
                        wt2[8] = {w2a[0], w2a[1], w2a[2], w2a[3], w2b[0], w2b[1], w2b[2], w2b[3]};
            unsigned ow[4];
#pragma unroll
            for (int q = 0; q < 4; ++q) {
                const float ylo = wt0[2 * q] * (bf_lo(c2w[q]) * bf_lo(x2w[q])) + wt1[2 * q] * (bf_lo(c1w[q]) * bf_lo(x1w[q])) + wt2[2 * q] * (bf_lo(c0w[q]) * bf_lo(x0w[q]));
                const float yhi = wt0[2 * q + 1] * (bf_hi(c2w[q]) * bf_hi(x2w[q])) + wt1[2 * q + 1] * (bf_hi(c1w[q]) * bf_hi(x1w[q])) + wt2[2 * q + 1] * (bf_hi(c0w[q]) * bf_hi(x0w[q]));
                ow[q] = cvt_pk_bf16(bf_lo(gbw[q]) * ylo, bf_hi(gbw[q]) * yhi); }
            *(u32x4*)(mo + (size_t)tok * DM + 1024 + cB) = (u32x4){ow[0], ow[1], ow[2], ow[3]}; }
    }
}

__device__ __forceinline__ void attn_phase(LAS unsigned char* lds, unsigned ldsb, const bf16_t* __restrict__ qkv, bf16_t* __restrict__ part_o, float* __restrict__ lse) {
    constexpr int KP = 272, VP = 288, VOFF = 256 * KP;
    int tid = threadIdx.x; asm volatile("" : "+v"(tid));
    const int w = __builtin_amdgcn_readfirstlane(tid >> 6), lane = tid & 63, j = lane & 15, fq = lane >> 4;
    for (int item = blockIdx.x; item < 6144; item += gridDim.x) {
        const int br = item >> 11, rem = item & 2047, dsh = 2 * br, nb = 32 >> dsh;
        const int n = rem & (nb - 1), r = (rem & 31) >> (5 - dsh), h = (rem >> 5) & 15, b = rem >> 9;
        const size_t tokb = (size_t)b * SEQ + r;
        __syncthreads();
#pragma unroll
        for (int i = 0; i < 8; ++i) { const int c = tid + 512 * i, row = c >> 4, ck = c & 15, l = 128 * (n - 1) + row;
            u32x4 kv = (u32x4){0, 0, 0, 0}, vv = kv;
            if (l >= 0) { const bf16_t* p = qkv + (tokb + ((size_t)l << dsh)) * 6144 + h * 128 + ck * 8; kv = *(const u32x4*)(p + 2048); vv = *(const u32x4*)(p + 4096); }
            *(LAS u32x4*)(lds + row * KP + ck * 16) = kv; *(LAS u32x4*)(lds + VOFF + row * VP + ck * 16) = vv; }
        const size_t tokq = tokb + ((size_t)(128 * n + 16 * w + j) << dsh);
        bf16x8 qf[4];
        { const bf16_t* qp = qkv + tokq * 6144 + h * 128 + 8 * fq;
#pragma unroll
          for (int ks = 0; ks < 4; ++ks) qf[ks] = *(const bf16x8*)(qp + 32 * ks); }
        __syncthreads();
        f32x4 s[9];
#pragma unroll
        for (int i = 0; i < 9; ++i) { s[i] = (f32x4){0.f, 0.f, 0.f, 0.f};
            const LAS unsigned char* ka = lds + (16 * (w + i) + j) * KP + 16 * fq;
#pragma unroll
            for (int ks = 0; ks < 4; ++ks) s[i] = MFMA16(*(const LAS bf16x8*)(ka + 64 * ks), qf[ks], s[i]); }
        const float NEG = -__builtin_inff();
        float m = NEG;
#pragma unroll
        for (int i = 0; i < 9; ++i)
#pragma unroll
            for (int e = 0; e < 4; ++e) { const int ki = 16 * (w + i) + 4 * fq + e, step = j + 128 - 16 * i - 4 * fq - e;
                const bool ok = (step >= 0) && (step <= 128) && (n > 0 || ki >= 128);
                s[i][e] = ok ? s[i][e] : NEG; m = fmaxf(m, s[i][e]); }
        m = fmaxf(m, __shfl_xor(m, 16)); m = fmaxf(m, __shfl_xor(m, 32));
        float lsum = 0.f;
#pragma unroll
        for (int i = 0; i < 9; ++i)
#pragma unroll
            for (int e = 0; e < 4; ++e) { s[i][e] = __builtin_amdgcn_exp2f(s[i][e] - m); lsum += s[i][e]; }
        lsum += __shfl_xor(lsum, 16); lsum += __shfl_xor(lsum, 32);
        f32x4 o[8];
#pragma unroll
        for (int i = 0; i < 8; ++i) o[i] = (f32x4){0.f, 0.f, 0.f, 0.f};
        const unsigned vbase = ldsb + (unsigned)(VOFF + (16 * w + 4 * fq + (j >> 2)) * VP + (j & 3) * 8);
#pragma unroll
        for (int k2 = 0; k2 < 5; ++k2) { const int i0 = 2 * k2, i1 = (k2 < 4) ? 2 * k2 + 1 : 8;
            u32x4 pw; pw.x = cvt_pk_bf16(s[i0][0], s[i0][1]); pw.y = cvt_pk_bf16(s[i0][2], s[i0][3]);
            if (k2 < 4) { pw.z = cvt_pk_bf16(s[i1][0], s[i1][1]); pw.w = cvt_pk_bf16(s[i1][2], s[i1][3]); } else { pw.z = 0u; pw.w = 0u; }
            const bf16x8 pb = __builtin_bit_cast(bf16x8, pw);
            const unsigned alo = vbase + (unsigned)(16 * i0 * VP), ahi = vbase + (unsigned)(16 * i1 * VP);
            s16x4 lo[4], hi[4];
            tr8(alo, ahi, lo, hi);
#pragma unroll
            for (int c = 0; c < 4; ++c) o[c] = MFMA16(cat4(lo[c], hi[c]), pb, o[c]);
            tr8(alo + 128, ahi + 128, lo, hi);
#pragma unroll
            for (int c = 0; c < 4; ++c) o[4 + c] = MFMA16(cat4(lo[c], hi[c]), pb, o[4 + c]); }
        const float inv = 1.0f / lsum;
        bf16_t* op = part_o + ((size_t)br * T_TOK + tokq) * DM + h * 128 + 4 * fq;
#pragma unroll
        for (int c = 0; c < 8; ++c) { u32x2 ov; ov.x = cvt_pk_bf16(o[c][0] * inv, o[c][1] * inv); ov.y = cvt_pk_bf16(o[c][2] * inv, o[c][3] * inv); *(u32x2*)(op + 16 * c) = ov; }
        if (fq == 0) lse[((size_t)br * T_TOK + tokq) * 16 + h] = m + __builtin_amdgcn_logf(lsum);
    }
}
__device__ __forceinline__ void combine_phase(const bf16_t* __restrict__ part_o, const float* __restrict__ lse, bf16_t* __restrict__ mo) {
    int tid = threadIdx.x; asm volatile("" : "+v"(tid));
    for (int idx = blockIdx.x * 512 + tid; idx < T_TOK * 256; idx += gridDim.x * 512) {
        const int tok = idx >> 8, c8 = idx & 255, h = c8 >> 4;
        const float l0 = lse[(size_t)tok * 16 + h], l1 = lse[((size_t)T_TOK + tok) * 16 + h], l2 = lse[((size_t)2 * T_TOK + tok) * 16 + h];
        const float mx = fmaxf(l0, fmaxf(l1, l2));
        float w0 = __builtin_amdgcn_exp2f(l0 - mx), w1 = __builtin_amdgcn_exp2f(l1 - mx), w2 = __builtin_amdgcn_exp2f(l2 - mx);
        const float inv = 1.0f / (w0 + w1 + w2); w0 *= inv; w1 *= inv; w2 *= inv;
        const size_t off = (size_t)tok * DM + c8 * 8;
        const u32x4 a = *(const u32x4*)(part_o + off), bq = *(const u32x4*)(part_o + (size_t)T_TOK * DM + off), c = *(const u32x4*)(part_o + (size_t)2 * T_TOK * DM + off);
        const unsigned aw[4] = {a.x, a.y, a.z, a.w}, bw[4] = {bq.x, bq.y, bq.z, bq.w}, cw[4] = {c.x, c.y, c.z, c.w}; unsigned ow[4];
#pragma unroll
        for (int q = 0; q < 4; ++q) ow[q] = cvt_pk_bf16(w0 * bf_lo(aw[q]) + w1 * bf_lo(bw[q]) + w2 * bf_lo(cw[q]), w0 * bf_hi(aw[q]) + w1 * bf_hi(bw[q]) + w2 * bf_hi(cw[q]));
        *(u32x4*)(mo + off) = (u32x4){ow[0], ow[1], ow[2], ow[3]};
    }
}

__global__ void __launch_bounds__(512) hybrid_trunk_fwd(Params p) {
    extern __shared__ __attribute__((aligned(16))) unsigned char smem[];
    cg::grid_group grid = cg::this_grid();
    LAS unsigned char* lds = (LAS unsigned char*)smem;
    const unsigned ldsb = (unsigned)(uintptr_t)smem;
    unsigned char* ws = p.ws;
    bf16_t* Wt_in = (bf16_t*)(ws + OFF_WIN); bf16_t* Wt_out = (bf16_t*)(ws + OFF_WOUT); bf16_t* Wt_qkv = (bf16_t*)(ws + OFF_WQKV); bf16_t* Wt_o = (bf16_t*)(ws + OFF_WO);
    bf16_t* Wt_up = (bf16_t*)(ws + OFF_WUP); bf16_t* Wt_down = (bf16_t*)(ws + OFF_WDOWN); bf16_t* Wsp = (bf16_t*)(ws + OFF_WSP);
    float* cosT = (float*)(ws + OFF_ROPE); float* sinT = cosT + 4096 * 64; float* stats = (float*)(ws + OFF_STATS); float* lse = (float*)(ws + OFF_LSE);
    bf16_t* hn = (bf16_t*)(ws + OFF_HN); float* gout = (float*)(ws + OFF_GOUT); bf16_t* mo = (bf16_t*)(ws + OFF_MO); bf16_t* big = (bf16_t*)(ws + OFF_BIG);
    bf16_t* part_o = (bf16_t*)(ws + OFF_HN);
    float* h = p.out;
    const int gtid = blockIdx.x * 512 + threadIdx.x, gsz = gridDim.x * 512;

    transpose_cvt(lds, p.w_in, Wt_in, 2, 2048, 5120, 0);
    transpose_cvt(lds, p.w_out, Wt_out, 2, 2048, 2048, 0);
    transpose_cvt(lds, p.w_qkv, Wt_qkv, 2, 2048, 6144, 1);
    transpose_cvt(lds, p.w_o, Wt_o, 2, 2048, 2048, 0);
    transpose_cvt(lds, p.w_up, Wt_up, 4, 2048, 8192, 0);
    transpose_cvt(lds, p.w_down, Wt_down, 4, 8192, 2048, 0);
    for (int i = gtid; i < 4096 * 64; i += gsz) { const int pos = i >> 6, k = i & 63;
        const float inv_freq = powf(10000.0f, -(float)k * (2.0f / 128.0f)); const float ang = (float)pos * inv_freq;
        cosT[i] = cosf(ang); sinT[i] = sinf(ang); }
    for (int i = gtid; i < 2 * 8 * 128 * 128; i += gsz) { const int s = i & 127, t = (i >> 7) & 127;
        const float v = (s <= t) ? p.w_sp[i] : 0.f; const unsigned pk = cvt_pk_bf16(v, v); Wsp[i] = (bf16_t)(pk & 0xffffu); }
    norm_phase(nullptr, p.x, h, nullptr, p.n_mix_pre, hn, 0);
    grid.sync();

    for (int layer = 0; layer < 4; ++layer) {
        const int e = layer >> 1;
        pg8::StaticOrder S;
        if ((layer & 1) == 0) {
            { pg8::Gemm g{hn, Wt_in + (size_t)e * 5120 * 2048, T_TOK, 5120, 2048}; S.init(T_TOK, 5120, (int)gridDim.x, (int)blockIdx.x);
              pg8::EpiProj E{big, stats}; pg8::gemm_phase<pg8::EpiProj, pg8::StaticOrder>(lds, g, S, E, nullptr); }
            grid.sync();
            mixer_phase(lds, ldsb, big, stats, Wsp + (size_t)e * 8 * 128 * 128, p.b_sp + (size_t)e * 8 * 128, p.conv_w + (size_t)e * 3 * 1024, mo);
            grid.sync();
        } else {
            { pg8::Gemm g{hn, Wt_qkv + (size_t)e * 6144 * 2048, T_TOK, 6144, 2048}; S.init(T_TOK, 6144, (int)gridDim.x, (int)blockIdx.x);
              pg8::EpiQKV E{big, cosT, sinT}; pg8::gemm_phase<pg8::EpiQKV, pg8::StaticOrder>(lds, g, S, E, nullptr); }
            grid.sync();
            attn_phase(lds, ldsb, big, part_o, lse);
            grid.sync();
            combine_phase(part_o, lse, mo);
            grid.sync();
        }
        { const bf16_t* wt = ((layer & 1) == 0) ? (Wt_out + (size_t)e * 2048 * 2048) : (Wt_o + (size_t)e * 2048 * 2048);
          pg8::Gemm g{mo, wt, T_TOK, 2048, 2048}; S.init(T_TOK, 2048, (int)gridDim.x, (int)blockIdx.x);
          pg8::EpiF32 E{gout, DM}; pg8::gemm_phase<pg8::EpiF32, pg8::StaticOrder>(lds, g, S, E, nullptr); }
        grid.sync();
        norm_phase(gout, h, h, p.n_mix_post + layer * DM, p.n_mlp_pre + layer * DM, hn, 1);
        grid.sync();
        { pg8::Gemm g{hn, Wt_up + (size_t)layer * 8192 * 2048, T_TOK, 8192, 2048}; S.init(T_TOK, 8192, (int)gridDim.x, (int)blockIdx.x);
          pg8::EpiRelu2 E{big, 8192}; pg8::gemm_phase<pg8::EpiRelu2, pg8::StaticOrder>(lds, g, S, E, nullptr); }
        grid.sync();
        { pg8::Gemm g{big, Wt_down + (size_t)layer * 2048 * 8192, T_TOK, 2048, 8192}; S.init(T_TOK, 2048, (int)gridDim.x, (int)blockIdx.x);
          pg8::EpiF32 E{gout, DM}; pg8::gemm_phase<pg8::EpiF32, pg8::StaticOrder>(lds, g, S, E, nullptr); }
        grid.sync();
        norm_phase(gout, h, h, p.n_mlp_post + layer * DM, p.n_mix_pre + (layer < 3 ? layer + 1 : 0) * DM, hn, layer < 3 ? 1 : 2);
        grid.sync();
    }
}

extern "C" void kernel_launch(void* const* d_in, const int* in_sizes, int n_in, void* d_out, int out_size, void* d_ws, size_t ws_size, hipStream_t stream) {
    static int grid_blocks = 0;
    if (grid_blocks == 0) {
        if (n_in != 14 || out_size != T_TOK * DM || ws_size < WS_END) { fprintf(stderr, "kernel_launch: unexpected shapes (n_in %d out %d ws %zu need %zu)\n", n_in, out_size, ws_size, (size_t)WS_END); grid_blocks = -1; return; }
        int dev = 0, cus = 0, per_cu = 0;
        (void)hipGetDevice(&dev); (void)hipDeviceGetAttribute(&cus, hipDeviceAttributeMultiprocessorCount, dev);
        if (hipFuncSetAttribute((const void*)hybrid_trunk_fwd, hipFuncAttributeMaxDynamicSharedMemorySize, LDS_BYTES) != hipSuccess) { fprintf(stderr, "kernel_launch: hipFuncSetAttribute failed\n"); grid_blocks = -1; return; }
        if (hipOccupancyMaxActiveBlocksPerMultiprocessor(&per_cu, (const void*)hybrid_trunk_fwd, 512, LDS_BYTES) != hipSuccess || per_cu < 1) { (void)hipGetLastError(); per_cu = 1; }
        if (per_cu > 1) per_cu = 1;
        grid_blocks = cus * per_cu;
    }
    if (grid_blocks < 0) return;
    Params p{};
    p.x = (const float*)d_in[0]; p.n_mix_pre = (const float*)d_in[1]; p.n_mix_post = (const float*)d_in[2]; p.n_mlp_pre = (const float*)d_in[3]; p.n_mlp_post = (const float*)d_in[4];
    p.w_in = (const float*)d_in[5]; p.w_sp = (const float*)d_in[6]; p.b_sp = (const float*)d_in[7]; p.conv_w = (const float*)d_in[8]; p.w_out = (const float*)d_in[9];
    p.w_qkv = (const float*)d_in[10]; p.w_o = (const float*)d_in[11]; p.w_up = (const float*)d_in[12]; p.w_down = (const float*)d_in[13];
    p.out = (float*)d_out; p.ws = (unsigned char*)d_ws;
    void* args[] = {&p};
    hipError_t e = hipLaunchCooperativeKernel((const void*)hybrid_trunk_fwd, dim3(grid_blocks), dim3(512), args, LDS_BYTES, stream);
    if (e != hipSuccess) fprintf(stderr, "cooperative launch failed: %s (grid %d)\n", hipGetErrorString(e), grid_blocks);
}
```

```cpp
#include <hip/hip_runtime.h>
#include <hip/hip_cooperative_groups.h>
#include <cstdio>
#include <cstdint>
namespace cg = cooperative_groups;

#define PG8_LAS __attribute__((address_space(3)))
#define LAS __attribute__((address_space(3)))
typedef unsigned short bf16_t;
typedef short bf16x8 __attribute__((ext_vector_type(8)));
typedef short s16x4 __attribute__((ext_vector_type(4)));
typedef float f32x4 __attribute__((ext_vector_type(4)));
typedef float f32x2 __attribute__((ext_vector_type(2)));
typedef unsigned u32x4 __attribute__((ext_vector_type(4)));
typedef unsigned u32x2 __attribute__((ext_vector_type(2)));

constexpr int T_TOK = 16384, DM = 2048, SEQ = 4096;

__device__ __forceinline__ unsigned cvt_pk_bf16(float lo, float hi) { unsigned r; asm volatile("v_cvt_pk_bf16_f32 %0, %1, %2" : "=v"(r) : "v"(lo), "v"(hi)); return r; }
__device__ __forceinline__ float bf_lo(unsigned w) { return __uint_as_float(w << 16); }
__device__ __forceinline__ float bf_hi(unsigned w) { return __uint_as_float(w & 0xffff0000u); }
__device__ __forceinline__ float gelu_tanh(float x) {
    const float u = 0.7978845608028654f * (x + 0.044715f * x * x * x);
    const float e = __builtin_amdgcn_exp2f(-2.885390081777927f * u);
    return x * __builtin_amdgcn_rcpf(1.0f + e);
}

namespace pg8 {
constexpr int BM = 256, BK = 64, HALF = 128, HTB = HALF * BK * 2  , STAGE_BYTES = 8 * HTB, NXCD = 8, WGM = 8;

__host__ __device__ __forceinline__ int lds_byte(int r, int c) { const int st = (r >> 4) * 2 + (c >> 5), rr = r & 15, cc = c & 31, ob = rr * 64 + cc * 2; return st * 1024 + (ob ^ (((ob >> 9) & 1) << 5)); }
__host__ __device__ __forceinline__ void stage_rc(int b, int& R, int& C) { const int st = b / 1024, sb = b % 1024, swz = sb ^ (((sb >> 9) & 1) << 5); R = (st >> 1) * 16 + swz / 64; C = (st & 1) * 32 + (swz % 64) / 2; }
__host__ __device__ __forceinline__ int perm32(int rho) { const int n = rho >> 4, i = rho & 15; return 8 * (i >> 2) + 4 * n + (i & 3); }

struct Unit { int pm, pn; };
struct Gemm { const bf16_t* A; const bf16_t* Bt; int M, N, K; };

struct StaticOrder {
    int nM, nN, nwg, G, c;
    __host__ __device__ void init(int M, int N, int G_, int c_) { nM = M / BM; nN = N / BM; nwg = nM * nN; G = G_; c = c_; }
    __host__ __device__ bool next(int i, Unit& u) const {
        const long L = (long)i * G + c; if (L >= nwg) return false;
        int wgid = (int)L; { const int q = nwg / NXCD, r = nwg % NXCD, xcd = wgid % NXCD, off = wgid / NXCD; wgid = (xcd < r ? xcd * (q + 1) : r * (q + 1) + (xcd - r) * q) + off; }
        const int nig = WGM * nN, gid = wgid / nig, fm = gid * WGM, gsz = (nM - fm) < WGM ? (nM - fm) : WGM;
        u.pm = fm + ((wgid % nig) % gsz); u.pn = (wgid % nig) / gsz; return true;
    }
    __device__ __forceinline__ void a_ready(const Unit&) const {}
    __device__ __forceinline__ void done(const Unit&) const {}
};
struct EpiBf16 {
    static constexpr bool PERM = true, AFTER_DRAIN = false;
    bf16_t* O; int ldc;
    __device__ __forceinline__ void operator()(const f32x4 (&acc)[2][2][4][2], const Unit& u, int wr, int wc, int fr, int fq) const {
        const int row0 = u.pm * BM + wr * 64 + fr, col0 = u.pn * BM + wc * 32 + 8 * fq;
#pragma unroll
        for (int ai = 0; ai < 2; ++ai)
#pragma unroll
            for (int m = 0; m < 4; ++m) { bf16_t* rowp = O + (size_t)(row0 + ai * HALF + m * 16) * ldc + col0;
#pragma unroll
                for (int bj = 0; bj < 2; ++bj) { const f32x4 v0 = acc[ai][bj][m][0], v1 = acc[ai][bj][m][1];
                    u32x4 w; w.x = cvt_pk_bf16(v0[0], v0[1]); w.y = cvt_pk_bf16(v0[2], v0[3]); w.z = cvt_pk_bf16(v1[0], v1[1]); w.w = cvt_pk_bf16(v1[2], v1[3]);
                    *(u32x4*)(rowp + bj * HALF) = w; } }
    }
};
struct EpiProj {
    static constexpr bool PERM = true, AFTER_DRAIN = false;
    bf16_t* O; float* stats;
    __device__ __forceinline__ void operator()(const f32x4 (&acc)[2][2][4][2], const Unit& u, int wr, int wc, int fr, int fq) const {
        const int row0 = u.pm * BM + wr * 64 + fr, col0 = u.pn * BM + wc * 32 + 8 * fq;
        const bool act = u.pn < 8, st = (u.pn >= 4) && (u.pn < 8);
        if (u.pn >= 12) {
            const int zc = 3072 + (u.pn - 12) * 128 + wc * 32 + 8 * fq;
#pragma unroll
            for (int ai = 0; ai < 2; ++ai)
#pragma unroll
                for (int m = 0; m < 4; ++m) { const f32x4 z0 = acc[ai][0][m][0] * acc[ai][1][m][0], z1 = acc[ai][0][m][1] * acc[ai][1][m][1];
                    u32x4 w; w.x = cvt_pk_bf16(z0[0], z0[1]); w.y = cvt_pk_bf16(z0[2], z0[3]); w.z = cvt_pk_bf16(z1[0], z1[1]); w.w = cvt_pk_bf16(z1[2], z1[3]);
                    *(u32x4*)(O + (size_t)(row0 + ai * HALF + m * 16) * 5120 + zc) = w; }
            return;
        }
#pragma unroll
        for (int ai = 0; ai < 2; ++ai)
#pragma unroll
            for (int m = 0; m < 4; ++m) { const int row = row0 + ai * HALF + m * 16; bf16_t* rowp = O + (size_t)row * 5120 + col0; float s = 0.f, ss = 0.f;
#pragma unroll
                for (int bj = 0; bj < 2; ++bj) { f32x4 v0 = acc[ai][bj][m][0], v1 = acc[ai][bj][m][1];
                    if (act) {
#pragma unroll
                        for (int j = 0; j < 4; ++j) { v0[j] = gelu_tanh(v0[j]); v1[j] = gelu_tanh(v1[j]); }
                    }
                    u32x4 w; w.x = cvt_pk_bf16(v0[0], v0[1]); w.y = cvt_pk_bf16(v0[2], v0[3]); w.z = cvt_pk_bf16(v1[0], v1[1]); w.w = cvt_pk_bf16(v1[2], v1[3]);
                    if (st) {
                        const float a0 = bf_lo(w.x), a1 = bf_hi(w.x), a2 = bf_lo(w.y), a3 = bf_hi(w.y), a4 = bf_lo(w.z), a5 = bf_hi(w.z), a6 = bf_lo(w.w), a7 = bf_hi(w.w);
                        s += ((a0 + a1) + (a2 + a3)) + ((a4 + a5) + (a6 + a7));
                        ss += ((a0 * a0 + a1 * a1) + (a2 * a2 + a3 * a3)) + ((a4 * a4 + a5 * a5) + (a6 * a6 + a7 * a7)); }
                    *(u32x4*)(rowp + bj * HALF) = w; }
                if (st) { s += __shfl_xor(s, 16); s += __shfl_xor(s, 32); ss += __shfl_xor(ss, 16); ss += __shfl_xor(ss, 32);
                    if (fq == 0) *(f32x2*)(stats + ((size_t)row * 16 + (u.pn - 4) * 4 + wc) * 2) = (f32x2){s, ss}; } }
    }
};
struct EpiRelu2 {
    static constexpr bool PERM = true, AFTER_DRAIN = false;
    bf16_t* O; int ldc;
    __device__ __forceinline__ void operator()(const f32x4 (&acc)[2][2][4][2], const Unit& u, int wr, int wc, int fr, int fq) const {
        const int row0 = u.pm * BM + wr * 64 + fr, col0 = u.pn * BM + wc * 32 + 8 * fq;
#pragma unroll
        for (int ai = 0; ai < 2; ++ai)
#pragma unroll
            for (int m = 0; m < 4; ++m) { bf16_t* rowp = O + (size_t)(row0 + ai * HALF + m * 16) * ldc + col0;
#pragma unroll
                for (int bj = 0; bj < 2; ++bj) { f32x4 v0 = acc[ai][bj][m][0], v1 = acc[ai][bj][m][1];
#pragma unroll
                    for (int j = 0; j < 4; ++j) { const float a = fmaxf(v0[j], 0.f), b = fmaxf(v1[j], 0.f); v0[j] = a * a; v1[j] = b * b; }
                    u32x4 w; w.x = cvt_pk_bf16(v0[0], v0[1]); w.y = cvt_pk_bf16(v0[2], v0[3]); w.z = cvt_pk_bf16(v1[0], v1[1]); w.w = cvt_pk_bf16(v1[2], v1[3]);
                    *(u32x4*)(rowp + bj * HALF) = w; } }
    }
};
struct EpiQKV {
    static constexpr bool PERM = true, AFTER_DRAIN = false;
    bf16_t* O; const float* cosT; const float* sinT;
    __device__ __forceinline__ void operator()(const f32x4 (&acc)[2][2][4][2], const Unit& u, int wr, int wc, int fr, int fq) const {
        const int row0 = u.pm * BM + wr * 64 + fr, dlo = (wc & 1) * 32 + 8 * fq, head = (u.pn & 7) * 2 + (wc >> 1);
        const bool rot = u.pn < 16; const float qs = (u.pn < 8) ? (0.08838834764831845f * 1.4426950408889634f) : 1.0f;
        bf16_t* base = O + (size_t)(u.pn >> 3) * ((size_t)T_TOK * DM) + (size_t)head * (SEQ * 128) + dlo;
#pragma unroll
        for (int ai = 0; ai < 2; ++ai)
#pragma unroll
            for (int m = 0; m < 4; ++m) { const int row = row0 + ai * HALF + m * 16, pos = row & (SEQ - 1);
                bf16_t* rowp = base + (size_t)(row >> 12) * (16 * SEQ * 128) + (size_t)pos * 128;
                f32x4 x1a = acc[ai][0][m][0], x1b = acc[ai][0][m][1], x2a = acc[ai][1][m][0], x2b = acc[ai][1][m][1];
                if (rot) { const float* cp = cosT + pos * 64 + dlo; const float* sp = sinT + pos * 64 + dlo;
                    const f32x4 ca = *(const f32x4*)cp, cb = *(const f32x4*)(cp + 4), sa = *(const f32x4*)sp, sb = *(const f32x4*)(sp + 4);
                    const f32x4 o1a = (x1a * ca - x2a * sa) * qs, o1b = (x1b * cb - x2b * sb) * qs, o2a = (x2a * ca + x1a * sa) * qs, o2b = (x2b * cb + x1b * sb) * qs;
                    x1a = o1a; x1b = o1b; x2a = o2a; x2b = o2b; }
                u32x4 w1, w2; w1.x = cvt_pk_bf16(x1a[0], x1a[1]); w1.y = cvt_pk_bf16(x1a[2], x1a[3]); w1.z = cvt_pk_bf16(x1b[0], x1b[1]); w1.w = cvt_pk_bf16(x1b[2], x1b[3]);
                w2.x = cvt_pk_bf16(x2a[0], x2a[1]); w2.y = cvt_pk_bf16(x2a[2], x2a[3]); w2.z = cvt_pk_bf16(x2b[0], x2b[1]); w2.w = cvt_pk_bf16(x2b[2], x2b[3]);
                *(u32x4*)rowp = w1; *(u32x4*)(rowp + 64) = w2; }
    }
};

template <class Epi, class Sched, bool STAMP = false>
__device__ __forceinline__ void gemm_phase(PG8_LAS unsigned char* lds, const Gemm g, const Sched& S, const Epi& E, unsigned long long* stamps) {
    int tid = threadIdx.x; asm volatile("" : "+v"(tid));
    const int wid = __builtin_amdgcn_readfirstlane(tid >> 6), lane = tid & 63, wr = wid >> 2, wc = wid & 3, fr = lane & 15, fq = lane >> 4;
    const int K = g.K, nt = K / BK;
    int ts_lo = 0, ts_hi = 0, nts = 0; const unsigned long long rt_entry = STAMP ? (unsigned long long)wall_clock64() : 0ull;
#define PG8_STAMP() do { if (STAMP && wid == 0 && nts < 64) { const unsigned long long _c = (unsigned long long)clock64(); \
        ts_lo = (lane == nts) ? (int)(unsigned)_c : ts_lo; ts_hi = (lane == nts) ? (int)(unsigned)(_c >> 32) : ts_hi; ++nts; } } while (0)
    PG8_STAMP();
    unsigned voffA[2], voffB[2];
#pragma unroll
    for (int i = 0; i < 2; ++i) { int R, C; stage_rc(tid * 16 + i * 8192, R, C); const int Rb = Epi::PERM ? ((R & ~31) + perm32(R & 31)) : R;
        voffA[i] = (unsigned)(R * K + C) * 2u; voffB[i] = (unsigned)(Rb * K + C) * 2u; }
    const size_t kstep = (size_t)(BK * 2);
    const size_t hstep = (size_t)HALF * K * 2;
    const size_t tstep = 2 * hstep;
    const unsigned ldsw = (unsigned)wid * 1024u;
    const int aoff = lds_byte(wr * 64 + fr, fq * 8), boff = lds_byte(wc * 32 + fr, fq * 8);
#define PG8_SA(b, h) (((b) * 2 + (h)) * HTB)
#define PG8_SB(b, h) ((4 + (b) * 2 + (h)) * HTB)
#define PG8_STAGE(bufoff, gbase, voff) do { _Pragma("unroll") for (int _i = 0; _i < 2; ++_i) \
        __builtin_amdgcn_global_load_lds((const unsigned*)((const char*)(gbase) + (voff)[_i]), (PG8_LAS unsigned*)(lds + (bufoff) + ldsw + _i * 8192), 16, 0, 0); } while (0)
#define PG8_LDA(dst, b, h) do { _Pragma("unroll") for (int m = 0; m < 4; ++m) _Pragma("unroll") for (int k = 0; k < 2; ++k) dst[m][k] = *(const PG8_LAS bf16x8*)(lds + PG8_SA(b, h) + aoff + m * 2048 + k * 1024); } while (0)
#define PG8_LDB(dst, b, h) do { _Pragma("unroll") for (int n = 0; n < 2; ++n) _Pragma("unroll") for (int k = 0; k < 2; ++k) dst[n][k] = *(const PG8_LAS bf16x8*)(lds + PG8_SB(b, h) + boff + n * 2048 + k * 1024); } while (0)
#define PG8_MMA(ai, bj, At, Bt) do { __builtin_amdgcn_s_setprio(1); _Pragma("unroll") for (int m = 0; m < 4; ++m) _Pragma("unroll") for (int n = 0; n < 2; ++n) _Pragma("unroll") for (int k = 0; k < 2; ++k) \
        acc[ai][bj][m][n] = __builtin_amdgcn_mfma_f32_16x16x32_bf16(Bt[n][k], At[m][k], acc[ai][bj][m][n], 0, 0, 0); __builtin_amdgcn_s_setprio(0); } while (0)
#define PG8_WAIT_V(n) asm volatile("s_waitcnt vmcnt(" #n ")" ::: "memory")
#define PG8_WAIT_L(n) asm volatile("s_waitcnt lgkmcnt(" #n ")" ::: "memory")
#define PG8_BAR __builtin_amdgcn_s_barrier()
#define PG8_SCHED __builtin_amdgcn_sched_barrier(0)
    Unit cur, nxt; int ui = 0;
    if (!S.next(0, cur)) return;
    f32x4 acc[2][2][4][2];
#pragma unroll
    for (int a = 0; a < 2; ++a)
#pragma unroll
        for (int b = 0; b < 2; ++b)
#pragma unroll
            for (int m = 0; m < 4; ++m)
#pragma unroll
                for (int n = 0; n < 2; ++n) acc[a][b][m][n] = (f32x4){0.f, 0.f, 0.f, 0.f};
    bf16x8 At[4][2], B0[2][2], B1[2][2];
    const char* cA = (const char*)g.A + (size_t)cur.pm * tstep; const char* cB = (const char*)g.Bt + (size_t)cur.pn * tstep;
    S.a_ready(cur);
    PG8_STAGE(PG8_SB(0, 0), cB, voffB); PG8_STAGE(PG8_SA(0, 0), cA, voffA); PG8_STAGE(PG8_SB(0, 1), cB + hstep, voffB); PG8_STAGE(PG8_SA(0, 1), cA + hstep, voffA);
    if (wr == 1) PG8_BAR;
    PG8_WAIT_V(4); PG8_BAR;
    PG8_STAGE(PG8_SB(1, 0), cB + kstep, voffB); PG8_STAGE(PG8_SA(1, 0), cA + kstep, voffA); PG8_STAGE(PG8_SB(1, 1), cB + hstep + kstep, voffB);
    PG8_WAIT_V(6); PG8_BAR;
    PG8_STAMP();
    for (;;) {
        const bool has_next = S.next(ui + 1, nxt);
        const char* nA = has_next ? (const char*)g.A + (size_t)nxt.pm * tstep : cA; const char* nB = has_next ? (const char*)g.Bt + (size_t)nxt.pn * tstep : cB;
        for (int t = 0; t < nt; t += 2) {
            const bool last = (t == nt - 2);
            const char* a1 = cA + (size_t)(t + 1) * kstep;
            const char* a2 = last ? nA : cA + (size_t)(t + 2) * kstep; const char* b2 = last ? nB : cB + (size_t)(t + 2) * kstep;
            const char* a3 = a2 + kstep; const char* b3 = b2 + kstep;
            if (last && has_next) S.a_ready(nxt);
            PG8_LDB(B0, 0, 0); PG8_SCHED; PG8_LDA(At, 0, 0); PG8_STAGE(PG8_SA(1, 1), a1 + hstep, voffA);
            PG8_WAIT_L(8); PG8_BAR; PG8_WAIT_L(0); PG8_MMA(0, 0, At, B0); PG8_BAR; PG8_SCHED;
            PG8_LDB(B1, 0, 1); PG8_STAGE(PG8_SB(0, 0), b2, voffB);
            PG8_BAR; PG8_WAIT_L(0); PG8_MMA(0, 1, At, B1); PG8_BAR;
            PG8_LDA(At, 0, 1); PG8_STAGE(PG8_SA(0, 0), a2, voffA);
            PG8_BAR; PG8_WAIT_L(0); PG8_MMA(1, 0, At, B0); PG8_BAR; PG8_SCHED;
            PG8_STAGE(PG8_SB(0, 1), b2 + hstep, voffB);
            PG8_WAIT_V(6); PG8_BAR; PG8_MMA(1, 1, At, B1); PG8_BAR;
            PG8_LDB(B0, 1, 0); PG8_SCHED; PG8_LDA(At, 1, 0); PG8_STAGE(PG8_SA(0, 1), a2 + hstep, voffA);
            PG8_WAIT_L(8); PG8_BAR; PG8_WAIT_L(0); PG8_MMA(0, 0, At, B0); PG8_BAR; PG8_SCHED;
            PG8_LDB(B1, 1, 1); PG8_STAGE(PG8_SB(1, 0), b3, voffB);
            PG8_BAR; PG8_WAIT_L(0); PG8_MMA(0, 1, At, B1); PG8_BAR;
            PG8_LDA(At, 1, 1); PG8_STAGE(PG8_SA(1, 0), a3, voffA);
            PG8_BAR; PG8_WAIT_L(0); PG8_MMA(1, 0, At, B0); PG8_BAR; PG8_SCHED;
            PG8_STAGE(PG8_SB(1, 1), b3 + hstep, voffB);
            PG8_WAIT_V(6); PG8_BAR; PG8_MMA(1, 1, At, B1); PG8_BAR;
        }
        PG8_STAMP();
        if constexpr (!Epi::AFTER_DRAIN) { E(acc, cur, wr, wc, fr, fq); S.done(cur); }
        PG8_STAMP();
        if (!has_next) break;
#pragma unroll
        for (int a = 0; a < 2; ++a)
#pragma unroll
            for (int b = 0; b < 2; ++b)
#pragma unroll
                for (int m = 0; m < 4; ++m)
#pragma unroll
                    for (int n = 0; n < 2; ++n) acc[a][b][m][n] = (f32x4){0.f, 0.f, 0.f, 0.f};
        cur = nxt; cA = nA; cB = nB; ++ui;
    }
    PG8_WAIT_V(0);
    if (wr == 0) PG8_BAR;
    PG8_BAR;
    if constexpr (Epi::AFTER_DRAIN) { E.fused(acc, cur, wr, wc, fr, fq, lds, wid, lane); S.done(cur); }
    PG8_STAMP();
    if (STAMP && wid == 0) { stamps[lane] = lane < nts ? (((unsigned long long)(unsigned)ts_hi << 32) | (unsigned)ts_lo) : 0ull;
        if (lane == 62) stamps[62] = rt_entry; if (lane == 63) stamps[63] = (unsigned long long)wall_clock64(); }
#undef PG8_STAMP
#undef PG8_SA
#undef PG8_SB
#undef PG8_STAGE
#undef PG8_LDA
#undef PG8_LDB
#undef PG8_MMA
#undef PG8_WAIT_V
#undef PG8_WAIT_L
#undef PG8_BAR
#undef PG8_SCHED
}}

#define XB_TMO      128
#define XB_XCNT(j)  (256  + 64 * (j))
#define XB_XSUB(j)  (1280 + 64 * (j))
#define XB_XGEN(j)  (2304 + 64 * (j))
#define XB_TOP      3328
#define XB_TOPGEN   3392
#define XCD_BAR_WORDS 3456
#define XB_SPIN_CAP (1u << 22)

__device__ __forceinline__ unsigned xb_ld(unsigned* p)              { return __hip_atomic_load(p, __ATOMIC_RELAXED, __HIP_MEMORY_SCOPE_AGENT); }
__device__ __forceinline__ unsigned xb_add(unsigned* p, unsigned v) { return __hip_atomic_fetch_add(p, v, __ATOMIC_RELAXED, __HIP_MEMORY_SCOPE_AGENT); }
__device__ __forceinline__ unsigned xb_xcc_id() { return (unsigned)__builtin_amdgcn_s_getreg((3 << 11) | 20) & 0xFu; }
#define XB_SPIN(cond, bar) do { unsigned _sp = 0; while (cond) { __builtin_amdgcn_s_sleep(1); \
    if ((++_sp & 255u) == 0u) { if (xb_ld(&(bar)[XB_TMO])) break; if (_sp > XB_SPIN_CAP) { atomicAdd(&(bar)[XB_TMO], 1u); break; } } } } while (0)

struct XcdBarrier {
    unsigned* bar; unsigned x;
    volatile LAS unsigned* st;
};

__device__ __forceinline__ XcdBarrier xcd_barrier_post(unsigned* bar, volatile LAS unsigned* st) {
    XcdBarrier b; b.bar = bar; b.x = xb_xcc_id(); b.st = st;
    if (threadIdx.x == 0) (void)xb_add(&bar[XB_XCNT(b.x)], 1u);
    return b;
}
__device__ __forceinline__ void xcd_barrier_complete(unsigned* bar, unsigned x, unsigned& nloc, unsigned& nx) {
    const unsigned G = gridDim.x * gridDim.y * gridDim.z;
    unsigned sum, cnt, mine, sp = 0u;
    for (;;) {
        sum = 0u; cnt = 0u; mine = 0u;
#pragma unroll
        for (unsigned j = 0; j < 16; ++j) { const unsigned c = xb_ld(&bar[XB_XCNT(j)]); sum += c; cnt += (c > 0u) ? 1u : 0u; mine = (j == x) ? c : mine; }
        if (sum == G) break;
        __builtin_amdgcn_s_sleep(1);
        if ((++sp & 255u) == 0u) { if (xb_ld(&bar[XB_TMO])) break; if (sp > XB_SPIN_CAP) { atomicAdd(&bar[XB_TMO], 1u); break; } }
    }
    nloc = mine > 0u ? mine : 1u; nx = cnt > 0u ? cnt : 1u;
}

__device__ __forceinline__ void xcd_barrier(const XcdBarrier& b) {
    asm volatile("s_waitcnt vmcnt(0)" ::: "memory");
    __syncthreads();
    if (threadIdx.x == 0) {
        unsigned* bar = b.bar;
        __builtin_amdgcn_s_waitcnt(0);
        unsigned nloc = b.st[0], nx = b.st[1];
        if (nloc == 0u) { xcd_barrier_complete(bar, b.x, nloc, nx); b.st[0] = nloc; b.st[1] = nx; }
        const unsigned old = xb_add(&bar[XB_XSUB(b.x)], 1u);
        const unsigned gen = old / nloc;
        if (old + 1u == (gen + 1u) * nloc) {
            __builtin_amdgcn_fence(__ATOMIC_RELEASE, "agent");
            asm volatile("s_waitcnt vmcnt(0)" ::: "memory");
            const unsigned og = xb_add(&bar[XB_TOP], 1u);
            const unsigned tg = og / nx;
            if (og + 1u == (tg + 1u) * nx) xb_add(&bar[XB_TOPGEN], 1u);
            else XB_SPIN(xb_ld(&bar[XB_TOPGEN]) == tg, bar);
            __builtin_amdgcn_fence(__ATOMIC_ACQUIRE, "agent");
            xb_add(&bar[XB_XGEN(b.x)], 1u);
            asm volatile("s_waitcnt vmcnt(0)" ::: "memory");
        } else {
            XB_SPIN(xb_ld(&bar[XB_XGEN(b.x)]) == gen, bar);
            __builtin_amdgcn_fence(__ATOMIC_ACQUIRE, "agent");
            asm volatile("s_waitcnt vmcnt(0)" ::: "memory");
        }
    }
    __syncthreads();
}

constexpr size_t SZ_WIN = (size_t)2 * 5120 * 2048 * 2, SZ_W22 = (size_t)2 * 2048 * 2048 * 2, SZ_WQKV = (size_t)2 * 6144 * 2048 * 2, SZ_WUP = (size_t)4 * 8192 * 2048 * 2;
constexpr size_t OFF_WIN = 0, OFF_WOUT = OFF_WIN + SZ_WIN, OFF_WQKV = OFF_WOUT + SZ_W22, OFF_WO = OFF_WQKV + SZ_WQKV, OFF_WUP = OFF_WO + SZ_W22, OFF_WDOWN = OFF_WUP + SZ_WUP;
constexpr size_t OFF_WSP = OFF_WDOWN + SZ_WUP;
constexpr size_t OFF_ROPE = OFF_WSP + (size_t)2 * 8 * 128 * 128 * 2;
constexpr size_t OFF_STATS = OFF_ROPE + (size_t)2 * 4096 * 64 * 4;
constexpr size_t OFF_LSE = OFF_STATS + (size_t)T_TOK * 16 * 8;
constexpr size_t OFF_HN = OFF_LSE + (size_t)3 * T_TOK * 16 * 4;
constexpr size_t OFF_GOUT = OFF_HN + (size_t)T_TOK * DM * 2;
constexpr size_t OFF_MO = OFF_GOUT + (size_t)T_TOK * DM * 4;
constexpr size_t OFF_BIG = OFF_MO + (size_t)T_TOK * DM * 2;
constexpr size_t OFF_BAR = OFF_BIG + (size_t)T_TOK * 8192 * 2;
constexpr size_t BAR_BYTES = 16384;
constexpr size_t OFF_RB = OFF_BAR + BAR_BYTES;
constexpr size_t WS_END = OFF_RB + (size_t)T_TOK * 4;
constexpr int LDS_MAIN = 143360;
constexpr int LDS_XB = LDS_MAIN + 16384 + 1024;
constexpr int LDS_BYTES = LDS_XB + 16;
#define GSYNC() xcd_barrier(xb)

struct Params {
    const float* x; const float* n_mix_pre; const float* n_mix_post; const float* n_mlp_pre; const float* n_mlp_post;
    const float* w_in; const float* w_sp; const float* b_sp; const float* conv_w; const float* w_out; const float* w_qkv; const float* w_o; const float* w_up; const float* w_down;
    float* out; unsigned char* ws;
};

__device__ __forceinline__ void transpose_cvt(LAS unsigned char* lds, const float* __restrict__ W, bf16_t* __restrict__ Wt, int L, int K, int N, int perm) {
    int tid = threadIdx.x; asm volatile("" : "+v"(tid));
    const int tk = K >> 7, tn = N >> 6, per = tk * tn, ntile = L * per;
    const int kp0 = tid >> 4, c4 = tid & 15;
    f32x4 ra[2], rb[2];
#define TR_LOAD(t_) do { const int l_ = (t_) / per, r_ = (t_) - l_ * per, kt_ = r_ / tn, nt_ = r_ - kt_ * tn; const float* src_ = W + ((size_t)l_ * K + (size_t)kt_ * 128) * N + nt_ * 64 + 4 * c4; \
        _Pragma("unroll") for (int i_ = 0; i_ < 2; ++i_) { const int kp_ = kp0 + 32 * i_; ra[i_] = *(const f32x4*)(src_ + (size_t)(2 * kp_) * N); rb[i_] = *(const f32x4*)(src_ + (size_t)(2 * kp_ + 1) * N); } } while (0)
    int t = blockIdx.x;
    if (t < ntile) TR_LOAD(t);
    for (; t < ntile; t += gridDim.x) {
        const int l = t / per, r = t - l * per, kt = r / tn, nt = r - kt * tn;
        __syncthreads();
#pragma unroll
        for (int i = 0; i < 2; ++i) { const int kp = kp0 + 32 * i;
#pragma unroll
            for (int j = 0; j < 4; ++j) *(LAS unsigned*)(lds + (4 * c4 + j) * 272 + kp * 4) = cvt_pk_bf16(ra[i][j], rb[i][j]); }
        if (t + (int)gridDim.x < ntile) TR_LOAD(t + (int)gridDim.x);
        __syncthreads();
#pragma unroll
        for (int i = 0; i < 2; ++i) { const int idx = tid + 512 * i, n = idx >> 4, kc = idx & 15;
            const u32x4 v = *(const LAS u32x4*)(lds + n * 272 + kc * 16);
            int ncol = nt * 64 + n;
            if (perm == 1) { const int nl = ncol & 255, hl = nl >> 7, dd = nl & 127; ncol = (ncol & ~255) + (dd >> 6) * 128 + hl * 64 + (dd & 63); }
            if (perm == 2 && ncol >= 3072) { const int q = ncol - 3072, c = q & 1023; ncol = 3072 + (c >> 7) * 256 + (q >> 10) * 128 + (c & 127); }
            *(u32x4*)(Wt + ((size_t)l * N + ncol) * K + kt * 128 + kc * 8) = v; }
    }
#undef TR_LOAD
}

__device__ __forceinline__ void norm_phase_b(const bf16_t* __restrict__ gin, bf16_t* hn, float* rbuf, float* __restrict__ outf, const float* __restrict__ gprev, const float* __restrict__ gpost, const float* __restrict__ gpre, int mode) {
    int tid = threadIdx.x; asm volatile("" : "+v"(tid));
    const int lane = tid & 63, w = tid >> 6;
    for (int row = blockIdx.x * 8 + w; row < T_TOK; row += gridDim.x * 8) {
        f32x4 ha[4], hc[4]; u32x4 gv[4]; bf16_t* hp = hn + (size_t)row * DM + 8 * lane; const bf16_t* gp = gin + (size_t)row * DM + 8 * lane; float ss = 0.f;
        const float rinv = __builtin_amdgcn_rcpf(rbuf[row]);
#pragma unroll
        for (int i = 0; i < 4; ++i) { const u32x4 hw = *(const u32x4*)(hp + 512 * i); gv[i] = *(const u32x4*)(gp + 512 * i);
            const f32x4 pa = *(const f32x4*)(gprev + 8 * lane + 512 * i), pb = *(const f32x4*)(gprev + 8 * lane + 512 * i + 4);
            ha[i] = ((f32x4){bf_lo(hw.x), bf_hi(hw.x), bf_lo(hw.y), bf_hi(hw.y)} * rinv) * (f32x4){__builtin_amdgcn_rcpf(pa[0]), __builtin_amdgcn_rcpf(pa[1]), __builtin_amdgcn_rcpf(pa[2]), __builtin_amdgcn_rcpf(pa[3])};
            hc[i] = ((f32x4){bf_lo(hw.z), bf_hi(hw.z), bf_lo(hw.w), bf_hi(hw.w)} * rinv) * (f32x4){__builtin_amdgcn_rcpf(pb[0]), __builtin_amdgcn_rcpf(pb[1]), __builtin_amdgcn_rcpf(pb[2]), __builtin_amdgcn_rcpf(pb[3])};
            const float a0 = bf_lo(gv[i].x), a1 = bf_hi(gv[i].x), a2 = bf_lo(gv[i].y), a3 = bf_hi(gv[i].y), a4 = bf_lo(gv[i].z), a5 = bf_hi(gv[i].z), a6 = bf_lo(gv[i].w), a7 = bf_hi(gv[i].w);
            ss += ((a0 * a0 + a1 * a1) + (a2 * a2 + a3 * a3)) + ((a4 * a4 + a5 * a5) + (a6 * a6 + a7 * a7)); }
#pragma unroll
        for (int o = 1; o < 64; o <<= 1) ss += __shfl_xor(ss, o);
        const float r = 1.0f / sqrtf(ss * (1.0f / DM) + 1e-6f);
        float ss2 = 0.f;
#pragma unroll
        for (int i = 0; i < 4; ++i) { const f32x4 ga = *(const f32x4*)(gpost + 8 * lane + 512 * i), gb = *(const f32x4*)(gpost + 8 * lane + 512 * i + 4);
            const f32x4 xa = (f32x4){bf_lo(gv[i].x), bf_hi(gv[i].x), bf_lo(gv[i].y), bf_hi(gv[i].y)}, xb = (f32x4){bf_lo(gv[i].z), bf_hi(gv[i].z), bf_lo(gv[i].w), bf_hi(gv[i].w)};
            ha[i] = ha[i] + (xa * r) * ga; hc[i] = hc[i] + (xb * r) * gb;
            ss2 += ((ha[i][0] * ha[i][0] + ha[i][1] * ha[i][1]) + (ha[i][2] * ha[i][2] + ha[i][3] * ha[i][3])) + ((hc[i][0] * hc[i][0] + hc[i][1] * hc[i][1]) + (hc[i][2] * hc[i][2] + hc[i][3] * hc[i][3])); }
        if (mode == 2) { float* op = outf + (size_t)row * DM + 8 * lane;
#pragma unroll
            for (int i = 0; i < 4; ++i) { *(f32x4*)(op + 512 * i) = ha[i]; *(f32x4*)(op + 512 * i + 4) = hc[i]; }
        } else {
#pragma unroll
            for (int o = 1; o < 64; o <<= 1) ss2 += __shfl_xor(ss2, o);
            const float r2 = 1.0f / sqrtf(ss2 * (1.0f / DM) + 1e-6f);
            if (lane == 0) rbuf[row] = r2;
#pragma unroll
            for (int i = 0; i < 4; ++i) { const f32x4 ga = *(const f32x4*)(gpre + 8 * lane + 512 * i), gb = *(const f32x4*)(gpre + 8 * lane + 512 * i + 4);
                const f32x4 ya = (ha[i] * r2) * ga, yb = (hc[i] * r2) * gb;
                u32x4 wv; wv.x = cvt_pk_bf16(ya[0], ya[1]); wv.y = cvt_pk_bf16(ya[2], ya[3]); wv.z = cvt_pk_bf16(yb[0], yb[1]); wv.w = cvt_pk_bf16(yb[2], yb[3]); *(u32x4*)(hp + 512 * i) = wv; }
        }
    }
}

__device__ __forceinline__ void init_phase(const float* __restrict__ x, float* __restrict__ rbuf, const float* __restrict__ gpre, bf16_t* __restrict__ hn) {
    int tid = threadIdx.x; asm volatile("" : "+v"(tid));
    const int lane = tid & 63, w = tid >> 6;
    for (int row = blockIdx.x * 8 + w; row < T_TOK; row += gridDim.x * 8) {
        f32x4 ha[4], hc[4]; const float* hp = x + (size_t)row * DM + 8 * lane; float ss = 0.f;
#pragma unroll
        for (int i = 0; i < 4; ++i) { ha[i] = *(const f32x4*)(hp + 512 * i); hc[i] = *(const f32x4*)(hp + 512 * i + 4);
            ss += ((ha[i][0] * ha[i][0] + ha[i][1] * ha[i][1]) + (ha[i][2] * ha[i][2] + ha[i][3] * ha[i][3])) + ((hc[i][0] * hc[i][0] + hc[i][1] * hc[i][1]) + (hc[i][2] * hc[i][2] + hc[i][3] * hc[i][3])); }
#pragma unroll
        for (int o = 1; o < 64; o <<= 1) ss += __shfl_xor(ss, o);
        const float r = 1.0f / sqrtf(ss * (1.0f / DM) + 1e-6f);
        if (lane == 0) rbuf[row] = r;
        bf16_t* np = hn + (size_t)row * DM + 8 * lane;
#pragma unroll
        for (int i = 0; i < 4; ++i) { const f32x4 ga = *(const f32x4*)(gpre + 8 * lane + 512 * i), gb = *(const f32x4*)(gpre + 8 * lane + 512 * i + 4);
            const f32x4 ya = (ha[i] * r) * ga, yb = (hc[i] * r) * gb;
            u32x4 wv; wv.x = cvt_pk_bf16(ya[0], ya[1]); wv.y = cvt_pk_bf16(ya[2], ya[3]); wv.z = cvt_pk_bf16(yb[0], yb[1]); wv.w = cvt_pk_bf16(yb[2], yb[3]); *(u32x4*)(np + 512 * i) = wv; }
    }
}

__device__ __forceinline__ void tr8(unsigned alo, unsigned ahi, s16x4 (&lo)[4], s16x4 (&hi)[4]) {
    asm volatile("ds_read_b64_tr_b16 %0, %8\n\tds_read_b64_tr_b16 %1, %8 offset:32\n\tds_read_b64_tr_b16 %2, %8 offset:64\n\tds_read_b64_tr_b16 %3, %8 offset:96\n\t"
                 "ds_read_b64_tr_b16 %4, %9\n\tds_read_b64_tr_b16 %5, %9 offset:32\n\tds_read_b64_tr_b16 %6, %9 offset:64\n\tds_read_b64_tr_b16 %7, %9 offset:96\n\t"
                 "s_waitcnt lgkmcnt(0)"
                 : "=&v"(lo[0]), "=&v"(lo[1]), "=&v"(lo[2]), "=&v"(lo[3]), "=&v"(hi[0]), "=&v"(hi[1]), "=&v"(hi[2]), "=&v"(hi[3]) : "v"(alo), "v"(ahi) : "memory");
}
__device__ __forceinline__ bf16x8 cat4(s16x4 a, s16x4 b) { return (bf16x8){a[0], a[1], a[2], a[3], b[0], b[1], b[2], b[3]}; }
#define MFMA16(a, b, c) __builtin_amdgcn_mfma_f32_16x16x32_bf16((a), (b), (c), 0, 0, 0)

__device__ __forceinline__ void mixer_phase(LAS unsigned char* lds, unsigned ldsb, const bf16_t* __restrict__ proj, const float* __restrict__ stats, const bf16_t* __restrict__ Wc,
                                            const float* __restrict__ b_s, const float* __restrict__ conv_w, bf16_t* __restrict__ mo) {
    constexpr int VP = 288;
    int tid = threadIdx.x; asm volatile("" : "+v"(tid));
    const int w = __builtin_amdgcn_readfirstlane(tid >> 6), lane = tid & 63, j = lane & 15, fq = lane >> 4;
    LAS float* mu_s = (LAS float*)(lds + 128 * VP); LAS float* rs_s = mu_s + 128;
    const bool xdeal = (gridDim.x == 256);
    for (int it0 = blockIdx.x, ii = 0; it0 < 1024; it0 += gridDim.x, ++ii) {
        const int item = xdeal ? (128 * ((int)blockIdx.x & 7) + 4 * ((int)blockIdx.x >> 3) + ii) : it0;
        const int ch = item >> 3, g = item & 7, tok0 = ch * 128;
        __syncthreads();
        if (tid < 128) { const f32x2* sp = (const f32x2*)(stats + (size_t)(tok0 + tid) * 32); float s = 0.f, ss = 0.f;
#pragma unroll
            for (int i = 0; i < 16; ++i) { const f32x2 v = sp[i]; s += v.x; ss += v.y; }
            const float mu = s * (1.0f / 1024.0f), var = fmaxf(ss * (1.0f / 1024.0f) - mu * mu, 0.f);
            mu_s[tid] = mu; rs_s[tid] = 1.0f / sqrtf(var + 1e-5f); }
        __syncthreads();
#pragma unroll
        for (int i = 0; i < 4; ++i) { const int c = tid + 512 * i, row = c >> 4, ck = c & 15;
            const u32x4 raw = *(const u32x4*)(proj + (size_t)(tok0 + row) * 5120 + 1024 + g * 128 + ck * 8);
            const float mu = mu_s[row], rs = rs_s[row]; u32x4 o;
            o.x = cvt_pk_bf16((bf_lo(raw.x) - mu) * rs, (bf_hi(raw.x) - mu) * rs); o.y = cvt_pk_bf16((bf_lo(raw.y) - mu) * rs, (bf_hi(raw.y) - mu) * rs);
            o.z = cvt_pk_bf16((bf_lo(raw.z) - mu) * rs, (bf_hi(raw.z) - mu) * rs); o.w = cvt_pk_bf16((bf_lo(raw.w) - mu) * rs, (bf_hi(raw.w) - mu) * rs);
            *(LAS u32x4*)(lds + row * VP + ck * 16) = o; }
        __syncthreads();
        const int t = 16 * w + j;
        const bf16_t* wp = Wc + (size_t)(g * 128 + t) * 128 + 4 * fq;
        f32x4 acc[8];
#pragma unroll
        for (int i = 0; i < 8; ++i) acc[i] = (f32x4){0.f, 0.f, 0.f, 0.f};
        const unsigned abase = ldsb + (unsigned)((4 * fq + (j >> 2)) * VP + (j & 3) * 8);
#pragma unroll
        for (int ks = 0; ks < 4; ++ks) {
            if (ks <= (w >> 1)) {
                const s16x4 b0 = *(const s16x4*)(wp + 32 * ks), b1 = *(const s16x4*)(wp + 32 * ks + 16);
                const bf16x8 b = cat4(b0, b1);
                s16x4 lo[4], hi[4];
                const unsigned alo = abase + (unsigned)(32 * ks * VP), ahi = alo + 16 * VP;
                tr8(alo, ahi, lo, hi);
#pragma unroll
                for (int c = 0; c < 4; ++c) acc[c] = MFMA16(cat4(lo[c], hi[c]), b, acc[c]);
                tr8(alo + 128, ahi + 128, lo, hi);
#pragma unroll
                for (int c = 0; c < 4; ++c) acc[4 + c] = MFMA16(cat4(lo[c], hi[c]), b, acc[4 + c]);
            }
        }
        {
            const float bias = b_s[g * 128 + t];
            const bf16_t* up = proj + (size_t)(tok0 + t) * 5120 + g * 128 + 4 * fq;
            bf16_t* op = mo + (size_t)(tok0 + t) * DM + g * 128 + 4 * fq;
#pragma unroll
            for (int c = 0; c < 8; ++c) { const u32x2 au = *(const u32x2*)(up + 16 * c); u32x2 o;
                o.x = cvt_pk_bf16(bf_lo(au.x) * (acc[c][0] + bias), bf_hi(au.x) * (acc[c][1] + bias));
                o.y = cvt_pk_bf16(bf_lo(au.y) * (acc[c][2] + bias), bf_hi(au.y) * (acc[c][3] + bias));
                *(u32x2*)(op + 16 * c) = o; }
        }
#pragma unroll
        for (int i = 0; i < 4; ++i) { const int c = tid + 512 * i, row = c >> 4, ck = c & 15, cB = g * 128 + ck * 8, tok = tok0 + row, pos = tok & (SEQ - 1);
            const bf16_t* pp = proj + (size_t)tok * 5120 + cB;
            const u32x4 gb = *(const u32x4*)(pp + 2048), z0 = *(const u32x4*)(pp + 3072);
            u32x4 z1 = (u32x4){0, 0, 0, 0}, z2 = z1;
            if (pos >= 1) z1 = *(const u32x4*)(pp - 5120 + 3072);
            if (pos >= 2) z2 = *(const u32x4*)(pp - 10240 + 3072);
            const f32x4 w0a = *(const f32x4*)(conv_w + cB), w0b = *(const f32x4*)(conv_w + cB + 4);
            const f32x4 w1a = *(const f32x4*)(conv_w + 1024 + cB), w1b = *(const f32x4*)(conv_w + 1024 + cB + 4);
            const f32x4 w2a = *(const f32x4*)(conv_w + 2048 + cB), w2b = *(const f32x4*)(conv_w + 2048 + cB + 4);
            const unsigned gbw[4] = {gb.x, gb.y, gb.z, gb.w}, z0w[4] = {z0.x, z0.y, z0.z, z0.w}, z1w[4] = {z1.x, z1.y, z1.z, z1.w}, z2w[4] = {z2.x, z2.y, z2.z, z2.w};
            const float wt0[8] = {w0a[0], w0a[1], w0a[2], w0a[3], w0b[0], w0b[1], w0b[2], w0b[3]}, wt1[8] = {w1a[0], w1a[1], w1a[2], w1a[3], w1b[0], w1b[1], w1b[2], w1b[3]},
                        wt2[8] = {w2a[0], w2a[1], w2a[2], w2a[3], w2b[0], w2b[1], w2b[2], w2b[3]};
            unsigned ow[4];
#pragma unroll
            for (int q = 0; q < 4; ++q) {
                const float ylo = wt0[2 * q] * bf_lo(z2w[q]) + wt1[2 * q] * bf_lo(z1w[q]) + wt2[2 * q] * bf_lo(z0w[q]);
                const float yhi = wt0[2 * q + 1] * bf_hi(z2w[q]) + wt1[2 * q + 1] * bf_hi(z1w[q]) + wt2[2 * q + 1] * bf_hi(z0w[q]);
                ow[q] = cvt_pk_bf16(bf_lo(gbw[q]) * ylo, bf_hi(gbw[q]) * yhi); }
            *(u32x4*)(mo + (size_t)tok * DM + 1024 + cB) = (u32x4){ow[0], ow[1], ow[2], ow[3]}; }
    }
}

__device__ __forceinline__ void attn_phase(LAS unsigned char* lds, unsigned ldsb, const bf16_t* __restrict__ qkv, bf16_t* __restrict__ part_o, float* __restrict__ lse, bf16_t* __restrict__ mo, const int stage) {
    constexpr int KP = 272, VP = 288, VOFF = 256 * KP;
    int tid = threadIdx.x; asm volatile("" : "+v"(tid));
    const int w = __builtin_amdgcn_readfirstlane(tid >> 6), lane = tid & 63, j = lane & 15, fq = lane >> 4;
    __syncthreads();
    for (int o = tid * 16; o < LDS_MAIN; o += 512 * 16) *(LAS u32x4*)(lds + o) = (u32x4){0u, 0u, 0u, 0u};
    const int nitems = stage ? 256 : 512;
    const int srow = tid >> 4, sck = tid & 15;
    for (int item = blockIdx.x; item < nitems; item += gridDim.x) {
        const int h = (item >> 2) & 15, b = (item >> 6) & 3, lowq = item & 3;
        int dsh, rbase, nbase, pbr; bool seq2;
        if (stage) { dsh = 0; rbase = 0; nbase = 8 * lowq; seq2 = false; pbr = 0; }
        else if (item < 256) { dsh = 2; rbase = lowq; nbase = 0; seq2 = false; pbr = 0; }
        else { dsh = 4; rbase = 4 * lowq; nbase = 0; seq2 = true; pbr = 1; }
        const bf16_t* qh = qkv + (size_t)(b * 16 + h) * (SEQ * 128);
        u32x4 kreg[4], vreg[4];
#define ATT_LOAD(r_, n_) do { _Pragma("unroll") for (int i_ = 0; i_ < 4; ++i_) { const bf16_t* p_ = qh + (size_t)((r_) + ((128 * (n_) + srow + 32 * i_) << dsh)) * 128 + sck * 8; \
            kreg[i_] = *(const u32x4*)(p_ + (size_t)T_TOK * DM); vreg[i_] = *(const u32x4*)(p_ + (size_t)2 * T_TOK * DM); } } while (0)
#define ATT_STORE(slot_) do { _Pragma("unroll") for (int i_ = 0; i_ < 4; ++i_) { const int row_ = (slot_) * 128 + srow + 32 * i_; \
            *(LAS u32x4*)(lds + row_ * KP + sck * 16) = kreg[i_]; *(LAS u32x4*)(lds + VOFF + row_ * VP + sck * 16) = vreg[i_]; } } while (0)
        __syncthreads();
        bf16x8 qf[4], qn[4];
#define ATT_QLOAD(dst_, r_, n_) do { const bf16_t* qp_ = qh + (size_t)((r_) + ((128 * (n_) + 16 * w + j) << dsh)) * 128 + 8 * fq; \
            _Pragma("unroll") for (int ks_ = 0; ks_ < 4; ++ks_) dst_[ks_] = *(const bf16x8*)(qp_ + 32 * ks_); } while (0)
        { if (stage && nbase > 0) { ATT_LOAD(rbase, nbase - 1); ATT_STORE(1); }
          ATT_LOAD(rbase, nbase); ATT_QLOAD(qf, rbase, nbase); ATT_STORE(0); }
        __syncthreads();
        for (int t = 0; t < 8; ++t) {
            const int n = seq2 ? (t & 1) : nbase + t;
            const int rr = rbase + (seq2 ? (t >> 1) : 0);
            if (t < 7) { const int t1 = t + 1; const int n1 = seq2 ? (t1 & 1) : nbase + t1; const int rr1 = rbase + (seq2 ? (t1 >> 1) : 0); ATT_LOAD(rr1, n1); ATT_QLOAD(qn, rr1, n1); }
            const int f8 = (t & 1) ? 0 : 8;
            const int sq0 = rr + ((128 * n + 16 * w) << dsh);
            const size_t tok0 = (size_t)b * SEQ + sq0;
            const int rq = lane >> 3, rc = lane & 7;
            u32x4 px1[2][2], px2[2][2]; float pl1 = 0.f, pl2 = 0.f;
            if (stage) { const bf16_t* p1 = part_o + tok0 * DM + h * 128 + rc * 8; const bf16_t* p2 = p1 + (size_t)T_TOK * DM;
#pragma unroll
                for (int hh = 0; hh < 2; ++hh)
#pragma unroll
                    for (int it = 0; it < 2; ++it) { const int q = 8 * it + rq; px1[hh][it] = *(const u32x4*)(p1 + (size_t)q * DM + hh * 64); px2[hh][it] = *(const u32x4*)(p2 + (size_t)q * DM + hh * 64); }
                pl1 = lse[(tok0 + j) * 16 + h]; pl2 = lse[((size_t)T_TOK + tok0 + j) * 16 + h]; }
            f32x4 s[9];
#pragma unroll
            for (int i = 0; i < 9; ++i) { s[i] = (f32x4){0.f, 0.f, 0.f, 0.f};
                const LAS unsigned char* ka = lds + (16 * ((w + i) ^ f8) + j) * KP + 16 * fq;
#pragma unroll
                for (int ks = 0; ks < 4; ++ks) s[i] = MFMA16(*(const LAS bf16x8*)(ka + 64 * ks), qf[ks], s[i]); }
            const float NEG = -__builtin_inff();
            float m = NEG;
#pragma unroll
            for (int i = 0; i < 9; ++i)
#pragma unroll
                for (int e = 0; e < 4; ++e) { const int ki = 16 * (w + i) + 4 * fq + e, step = j + 128 - 16 * i - 4 * fq - e;
                    const bool ok = (step >= 0) && (step <= 128) && (n > 0 || ki >= 128);
                    s[i][e] = ok ? s[i][e] : NEG; m = fmaxf(m, s[i][e]); }
            m = fmaxf(m, __shfl_xor(m, 16)); m = fmaxf(m, __shfl_xor(m, 32));
            float lsum = 0.f;
#pragma unroll
            for (int i = 0; i < 9; ++i)
#pragma unroll
                for (int e = 0; e < 4; ++e) { s[i][e] = __builtin_amdgcn_exp2f(s[i][e] - m); lsum += s[i][e]; }
            lsum += __shfl_xor(lsum, 16); lsum += __shfl_xor(lsum, 32);
            f32x4 o[8];
#pragma unroll
            for (int i = 0; i < 8; ++i) o[i] = (f32x4){0.f, 0.f, 0.f, 0.f};
            const unsigned vb = ldsb + (unsigned)(VOFF + (4 * fq + (j >> 2)) * VP + (j & 3) * 8);
#pragma unroll
            for (int k2 = 0; k2 < 5; ++k2) { const int i0 = 2 * k2, i1 = (k2 < 4) ? 2 * k2 + 1 : 8;
                u32x4 pw; pw.x = cvt_pk_bf16(s[i0][0], s[i0][1]); pw.y = cvt_pk_bf16(s[i0][2], s[i0][3]);
                if (k2 < 4) { pw.z = cvt_pk_bf16(s[i1][0], s[i1][1]); pw.w = cvt_pk_bf16(s[i1][2], s[i1][3]); } else { pw.z = 0u; pw.w = 0u; }
                const bf16x8 pb = __builtin_bit_cast(bf16x8, pw);
                const unsigned alo = vb + (unsigned)(16 * ((w + i0) ^ f8) * VP), ahi = vb + (unsigned)(16 * ((w + i1) ^ f8) * VP);
                s16x4 lo[4], hi[4];
                tr8(alo, ahi, lo, hi);
#pragma unroll
                for (int c = 0; c < 4; ++c) o[c] = MFMA16(cat4(lo[c], hi[c]), pb, o[c]);
                tr8(alo + 128, ahi + 128, lo, hi);
#pragma unroll
                for (int c = 0; c < 4; ++c) o[4 + c] = MFMA16(cat4(lo[c], hi[c]), pb, o[4 + c]); }
            const float l0 = m + __builtin_amdgcn_logf(lsum);
            LAS unsigned char* ost = lds + LDS_MAIN + w * 2048;
            if (!stage) {
                const float inv = 1.0f / lsum;
                if (fq == 0) lse[((size_t)pbr * T_TOK + tok0 + ((size_t)j << dsh)) * 16 + h] = l0;
#pragma unroll
                for (int hh = 0; hh < 2; ++hh) {
#pragma unroll
                    for (int c = 0; c < 4; ++c) { const int cc = 4 * hh + c; u32x2 ov; ov.x = cvt_pk_bf16(o[cc][0] * inv, o[cc][1] * inv); ov.y = cvt_pk_bf16(o[cc][2] * inv, o[cc][3] * inv); *(LAS u32x2*)(ost + j * 128 + c * 32 + fq * 8) = ov; }
                    asm volatile("s_waitcnt lgkmcnt(0)" ::: "memory");
                    bf16_t* op = part_o + ((size_t)pbr * T_TOK + tok0) * DM + h * 128 + hh * 64 + rc * 8;
#pragma unroll
                    for (int it = 0; it < 2; ++it) { const int q = 8 * it + rq; *(u32x4*)(op + ((size_t)q << dsh) * DM) = *(const LAS u32x4*)(ost + q * 128 + rc * 16); }
                    asm volatile("s_waitcnt lgkmcnt(0)" ::: "memory");
                }
            } else {
                const float l1 = pl1, l2 = pl2;
                const float mx = fmaxf(l0, fmaxf(l1, l2));
                const float w0 = __builtin_amdgcn_exp2f(l0 - mx), w1 = __builtin_amdgcn_exp2f(l1 - mx), w2 = __builtin_amdgcn_exp2f(l2 - mx);
                const float inv = 1.0f / (w0 + w1 + w2); const float a0 = w0 * inv / lsum;
                LAS float* wst = (LAS float*)(lds + LDS_MAIN + 16384 + w * 128);
                if (fq == 0) { wst[2 * j] = w1 * inv; wst[2 * j + 1] = w2 * inv; }
#pragma unroll
                for (int hh = 0; hh < 2; ++hh) {
#pragma unroll
                    for (int c = 0; c < 4; ++c) { const int cc = 4 * hh + c; u32x2 ov; ov.x = cvt_pk_bf16(o[cc][0] * a0, o[cc][1] * a0); ov.y = cvt_pk_bf16(o[cc][2] * a0, o[cc][3] * a0); *(LAS u32x2*)(ost + j * 128 + c * 32 + fq * 8) = ov; }
                    asm volatile("s_waitcnt lgkmcnt(0)" ::: "memory");
                    bf16_t* op = mo + tok0 * DM + h * 128 + hh * 64 + rc * 8;
#pragma unroll
                    for (int it = 0; it < 2; ++it) { const int q = 8 * it + rq; const u32x4 x0 = *(const LAS u32x4*)(ost + q * 128 + rc * 16);
                        const u32x4 x1 = px1[hh][it], x2 = px2[hh][it]; const float a1 = wst[2 * q], a2 = wst[2 * q + 1];
                        u32x4 ov; ov.x = cvt_pk_bf16(bf_lo(x0.x) + a1 * bf_lo(x1.x) + a2 * bf_lo(x2.x), bf_hi(x0.x) + a1 * bf_hi(x1.x) + a2 * bf_hi(x2.x));
                        ov.y = cvt_pk_bf16(bf_lo(x0.y) + a1 * bf_lo(x1.y) + a2 * bf_lo(x2.y), bf_hi(x0.y) + a1 * bf_hi(x1.y) + a2 * bf_hi(x2.y));
                        ov.z = cvt_pk_bf16(bf_lo(x0.z) + a1 * bf_lo(x1.z) + a2 * bf_lo(x2.z), bf_hi(x0.z) + a1 * bf_hi(x1.z) + a2 * bf_hi(x2.z));
                        ov.w = cvt_pk_bf16(bf_lo(x0.w) + a1 * bf_lo(x1.w) + a2 * bf_lo(x2.w), bf_hi(x0.w) + a1 * bf_hi(x1.w) + a2 * bf_hi(x2.w));
                        *(u32x4*)(op + (size_t)q * DM) = ov; }
                    asm volatile("s_waitcnt lgkmcnt(0)" ::: "memory");
                }
            }
            __syncthreads();
            if (t < 7) { ATT_STORE((t + 1) & 1);
#pragma unroll
                for (int ks = 0; ks < 4; ++ks) qf[ks] = qn[ks]; }
            __syncthreads();
        }
#undef ATT_LOAD
#undef ATT_QLOAD
#undef ATT_STORE
    }
}

__global__ void __launch_bounds__(512) hybrid_trunk_fwd(Params p) {
    extern __shared__ __attribute__((aligned(16))) unsigned char smem[];
    cg::grid_group grid = cg::this_grid();
    LAS unsigned char* lds = (LAS unsigned char*)smem;
    const unsigned ldsb = (unsigned)(uintptr_t)smem;
    unsigned char* ws = p.ws;
    bf16_t* Wt_in = (bf16_t*)(ws + OFF_WIN); bf16_t* Wt_out = (bf16_t*)(ws + OFF_WOUT); bf16_t* Wt_qkv = (bf16_t*)(ws + OFF_WQKV); bf16_t* Wt_o = (bf16_t*)(ws + OFF_WO);
    bf16_t* Wt_up = (bf16_t*)(ws + OFF_WUP); bf16_t* Wt_down = (bf16_t*)(ws + OFF_WDOWN); bf16_t* Wsp = (bf16_t*)(ws + OFF_WSP);
    float* cosT = (float*)(ws + OFF_ROPE); float* sinT = cosT + 4096 * 64; float* stats = (float*)(ws + OFF_STATS); float* lse = (float*)(ws + OFF_LSE);
    bf16_t* hn = (bf16_t*)(ws + OFF_HN); bf16_t* gout = (bf16_t*)(ws + OFF_GOUT); bf16_t* mo = (bf16_t*)(ws + OFF_MO); bf16_t* big = (bf16_t*)(ws + OFF_BIG);
    bf16_t* part_o = (bf16_t*)(ws + OFF_GOUT);
    float* h = p.out;
    float* rbuf = (float*)(ws + OFF_RB);
    const int gtid = blockIdx.x * 512 + threadIdx.x, gsz = gridDim.x * 512;
    volatile LAS unsigned* xst = (volatile LAS unsigned*)(lds + LDS_XB);
    if (threadIdx.x == 0) { xst[0] = 0u; xst[1] = 0u; }
    __syncthreads();
    const XcdBarrier xb = xcd_barrier_post((unsigned*)(ws + OFF_BAR), xst);

    grid.sync();
    {
    transpose_cvt(lds, p.w_in, Wt_in, 2, 2048, 5120, 2);
    transpose_cvt(lds, p.w_out, Wt_out, 2, 2048, 2048, 0);
    transpose_cvt(lds, p.w_qkv, Wt_qkv, 2, 2048, 6144, 1);
    transpose_cvt(lds, p.w_o, Wt_o, 2, 2048, 2048, 0);
    transpose_cvt(lds, p.w_up, Wt_up, 4, 2048, 8192, 0);
    transpose_cvt(lds, p.w_down, Wt_down, 4, 8192, 2048, 0);
    for (int i = gtid; i < 4096 * 64; i += gsz) { const int pos = i >> 6, k = i & 63;
        const float inv_freq = powf(10000.0f, -(float)k * (2.0f / 128.0f)); const float ang = (float)pos * inv_freq;
        cosT[i] = cosf(ang); sinT[i] = sinf(ang); }
    for (int i = gtid; i < 2 * 8 * 128 * 128; i += gsz) { const int s = i & 127, t = (i >> 7) & 127;
        const float v = (s <= t) ? p.w_sp[i] : 0.f; const unsigned pk = cvt_pk_bf16(v, v); Wsp[i] = (bf16_t)(pk & 0xffffu); }
    init_phase(p.x, rbuf, p.n_mix_pre, hn);
    }
    GSYNC();

    for (int layer = 0; layer < 4; ++layer) {
        const int e = layer >> 1;
        pg8::StaticOrder S;
        if ((layer & 1) == 0) {
            { pg8::Gemm g{hn, Wt_in + (size_t)e * 5120 * 2048, T_TOK, 5120, 2048}; S.init(T_TOK, 5120, (int)gridDim.x, (int)blockIdx.x);
              pg8::EpiProj E{big, stats}; pg8::gemm_phase<pg8::EpiProj, pg8::StaticOrder>(lds, g, S, E, nullptr); }
            GSYNC();
            mixer_phase(lds, ldsb, big, stats, Wsp + (size_t)e * 8 * 128 * 128, p.b_sp + (size_t)e * 8 * 128, p.conv_w + (size_t)e * 3 * 1024, mo);
            GSYNC();
        } else {
            { pg8::Gemm g{hn, Wt_qkv + (size_t)e * 6144 * 2048, T_TOK, 6144, 2048}; S.init(T_TOK, 6144, (int)gridDim.x, (int)blockIdx.x);
              pg8::EpiQKV E{big, cosT, sinT}; pg8::gemm_phase<pg8::EpiQKV, pg8::StaticOrder>(lds, g, S, E, nullptr); }
            GSYNC();
            attn_phase(lds, ldsb, big, part_o, lse, mo, 0);
            GSYNC();
            attn_phase(lds, ldsb, big, part_o, lse, mo, 1);
            GSYNC();
        }
        const bf16_t* wt2 = ((layer & 1) == 0) ? (Wt_out + (size_t)e * 2048 * 2048) : (Wt_o + (size_t)e * 2048 * 2048);
            { pg8::Gemm g{mo, wt2, T_TOK, 2048, 2048}; S.init(T_TOK, 2048, (int)gridDim.x, (int)blockIdx.x);
              pg8::EpiBf16 E{gout, DM}; pg8::gemm_phase<pg8::EpiBf16, pg8::StaticOrder>(lds, g, S, E, nullptr); }
            GSYNC();
            norm_phase_b(gout, hn, rbuf, h, p.n_mix_pre + layer * DM, p.n_mix_post + layer * DM, p.n_mlp_pre + layer * DM, 1);
            GSYNC();
        { pg8::Gemm g{hn, Wt_up + (size_t)layer * 8192 * 2048, T_TOK, 8192, 2048}; S.init(T_TOK, 8192, (int)gridDim.x, (int)blockIdx.x);
          pg8::EpiRelu2 E{big, 8192}; pg8::gemm_phase<pg8::EpiRelu2, pg8::StaticOrder>(lds, g, S, E, nullptr); }
        GSYNC();
            { pg8::Gemm g{big, Wt_down + (size_t)layer * 2048 * 8192, T_TOK, 2048, 8192}; S.init(T_TOK, 2048, (int)gridDim.x, (int)blockIdx.x);
              pg8::EpiBf16 E{gout, DM}; pg8::gemm_phase<pg8::EpiBf16, pg8::StaticOrder>(lds, g, S, E, nullptr); }
            GSYNC();
            norm_phase_b(gout, hn, rbuf, h, p.n_mlp_pre + layer * DM, p.n_mlp_post + layer * DM, p.n_mix_pre + (layer < 3 ? layer + 1 : 0) * DM, layer < 3 ? 1 : 2);
            if (layer < 3) GSYNC();
    }
}

extern "C" void kernel_launch(void* const* d_in, const int* in_sizes, int n_in, void* d_out, int out_size, void* d_ws, size_t ws_size, hipStream_t stream) {
    static int grid_blocks = 0;
    if (grid_blocks == 0) {
        if (n_in != 14 || out_size != T_TOK * DM || ws_size < WS_END) { fprintf(stderr, "kernel_launch: unexpected shapes (n_in %d out %d ws %zu need %zu)\n", n_in, out_size, ws_size, (size_t)WS_END); grid_blocks = -1; return; }
        int dev = 0, cus = 0, per_cu = 0;
        (void)hipGetDevice(&dev); (void)hipDeviceGetAttribute(&cus, hipDeviceAttributeMultiprocessorCount, dev);
        if (hipFuncSetAttribute((const void*)hybrid_trunk_fwd, hipFuncAttributeMaxDynamicSharedMemorySize, LDS_BYTES) != hipSuccess) { fprintf(stderr, "kernel_launch: hipFuncSetAttribute failed\n"); grid_blocks = -1; return; }
        if (hipOccupancyMaxActiveBlocksPerMultiprocessor(&per_cu, (const void*)hybrid_trunk_fwd, 512, LDS_BYTES) != hipSuccess || per_cu < 1) { (void)hipGetLastError(); per_cu = 1; }
        if (per_cu > 1) per_cu = 1;
        grid_blocks = cus * per_cu;
    }
    if (grid_blocks < 0) return;
    Params p{};
    p.x = (const float*)d_in[0]; p.n_mix_pre = (const float*)d_in[1]; p.n_mix_post = (const float*)d_in[2]; p.n_mlp_pre = (const float*)d_in[3]; p.n_mlp_post = (const float*)d_in[4];
    p.w_in = (const float*)d_in[5]; p.w_sp = (const float*)d_in[6]; p.b_sp = (const float*)d_in[7]; p.conv_w = (const float*)d_in[8]; p.w_out = (const float*)d_in[9];
    p.w_qkv = (const float*)d_in[10]; p.w_o = (const float*)d_in[11]; p.w_up = (const float*)d_in[12]; p.w_down = (const float*)d_in[13];
    p.out = (float*)d_out; p.ws = (unsigned char*)d_ws;
    if (hipMemsetAsync((unsigned char*)d_ws + OFF_BAR, 0, BAR_BYTES, stream) != hipSuccess) { fprintf(stderr, "kernel_launch: memset of barrier words failed\n"); return; }
    void* args[] = {&p};
    hipError_t e = hipLaunchCooperativeKernel((const void*)hybrid_trunk_fwd, dim3(grid_blocks), dim3(512), args, LDS_BYTES, stream);
    if (e != hipSuccess) fprintf(stderr, "cooperative launch failed: %s (grid %d)\n", hipGetErrorString(e), grid_blocks);
}
```

```cpp
#include <hip/hip_runtime.h>
#include <hip/hip_cooperative_groups.h>
#include <cstdio>
#include <cstdint>
namespace cg = cooperative_groups;

#define PG8_LAS __attribute__((address_space(3)))
#define LAS __attribute__((address_space(3)))
typedef unsigned short bf16_t;
typedef short bf16x8 __attribute__((ext_vector_type(8)));
typedef short s16x4 __attribute__((ext_vector_type(4)));
typedef float f32x4 __attribute__((ext_vector_type(4)));
typedef float f32x2 __attribute__((ext_vector_type(2)));
typedef unsigned u32x4 __attribute__((ext_vector_type(4)));
typedef unsigned u32x2 __attribute__((ext_vector_type(2)));

constexpr int T_TOK = 16384, DM = 2048, SEQ = 4096;

__device__ __forceinline__ unsigned cvt_pk_bf16(float lo, float hi) { unsigned r; asm volatile("v_cvt_pk_bf16_f32 %0, %1, %2" : "=v"(r) : "v"(lo), "v"(hi)); return r; }
__device__ __forceinline__ float bf_lo(unsigned w) { return __uint_as_float(w << 16); }
__device__ __forceinline__ float bf_hi(unsigned w) { return __uint_as_float(w & 0xffff0000u); }
__device__ __forceinline__ float gelu_tanh(float x) {
    const float u = 0.7978845608028654f * (x + 0.044715f * x * x * x);
    const float e = __builtin_amdgcn_exp2f(-2.885390081777927f * u);
    return x * __builtin_amdgcn_rcpf(1.0f + e);
}

namespace pg8 {
constexpr int BM = 256, BK = 64, HALF = 128, HTB = HALF * BK * 2  , STAGE_BYTES = 8 * HTB, NXCD = 8, WGM = 8;

__host__ __device__ __forceinline__ int lds_byte(int r, int c) { const int st = (r >> 4) * 2 + (c >> 5), rr = r & 15, cc = c & 31, ob = rr * 64 + cc * 2; return st * 1024 + (ob ^ (((ob >> 9) & 1) << 5)); }
__host__ __device__ __forceinline__ void stage_rc(int b, int& R, int& C) { const int st = b / 1024, sb = b % 1024, swz = sb ^ (((sb >> 9) & 1) << 5); R = (st >> 1) * 16 + swz / 64; C = (st & 1) * 32 + (swz % 64) / 2; }
__host__ __device__ __forceinline__ int perm32(int rho) { const int n = rho >> 4, i = rho & 15; return 8 * (i >> 2) + 4 * n + (i & 3); }

struct Unit { int pm, pn; };
struct Gemm { const bf16_t* A; const bf16_t* Bt; int M, N, K; };

struct StaticOrder {
    int nM, nN, nwg, G, c;
    __host__ __device__ void init(int M, int N, int G_, int c_) { nM = M / BM; nN = N / BM; nwg = nM * nN; G = G_; c = c_; }
    __host__ __device__ bool next(int i, Unit& u) const {
        const long L = (long)i * G + c; if (L >= nwg) return false;
        int wgid = (int)L; { const int q = nwg / NXCD, r = nwg % NXCD, xcd = wgid % NXCD, off = wgid / NXCD; wgid = (xcd < r ? xcd * (q + 1) : r * (q + 1) + (xcd - r) * q) + off; }
        const int nig = WGM * nN, gid = wgid / nig, fm = gid * WGM, gsz = (nM - fm) < WGM ? (nM - fm) : WGM;
        u.pm = fm + ((wgid % nig) % gsz); u.pn = (wgid % nig) / gsz; return true;
    }
    __device__ __forceinline__ void a_ready(const Unit&) const {}
    __device__ __forceinline__ void done(const Unit&) const {}
};
struct EpiBf16 {
    static constexpr bool PERM = true, AFTER_DRAIN = false;
    bf16_t* O; int ldc;
    __device__ __forceinline__ void operator()(const f32x4 (&acc)[2][2][4][2], const Unit& u, int wr, int wc, int fr, int fq) const {
        const int row0 = u.pm * BM + wr * 64 + fr, col0 = u.pn * BM + wc * 32 + 8 * fq;
#pragma unroll
        for (int ai = 0; ai < 2; ++ai)
#pragma unroll
            for (int m = 0; m < 4; ++m) { bf16_t* rowp = O + (size_t)(row0 + ai * HALF + m * 16) * ldc + col0;
#pragma unroll
                for (int bj = 0; bj < 2; ++bj) { const f32x4 v0 = acc[ai][bj][m][0], v1 = acc[ai][bj][m][1];
                    u32x4 w; w.x = cvt_pk_bf16(v0[0], v0[1]); w.y = cvt_pk_bf16(v0[2], v0[3]); w.z = cvt_pk_bf16(v1[0], v1[1]); w.w = cvt_pk_bf16(v1[2], v1[3]);
                    *(u32x4*)(rowp + bj * HALF) = w; } }
    }
};
struct EpiProj {
    static constexpr bool PERM = true, AFTER_DRAIN = false;
    bf16_t* O; float* stats;
    __device__ __forceinline__ void operator()(const f32x4 (&acc)[2][2][4][2], const Unit& u, int wr, int wc, int fr, int fq) const {
        const int row0 = u.pm * BM + wr * 64 + fr, col0 = u.pn * BM + wc * 32 + 8 * fq;
        const bool act = u.pn < 8, st = (u.pn >= 4) && (u.pn < 8);
        if (u.pn >= 12) {
            const int zc = 3072 + (u.pn - 12) * 128 + wc * 32 + 8 * fq;
#pragma unroll
            for (int ai = 0; ai < 2; ++ai)
#pragma unroll
                for (int m = 0; m < 4; ++m) { const f32x4 z0 = acc[ai][0][m][0] * acc[ai][1][m][0], z1 = acc[ai][0][m][1] * acc[ai][1][m][1];
                    u32x4 w; w.x = cvt_pk_bf16(z0[0], z0[1]); w.y = cvt_pk_bf16(z0[2], z0[3]); w.z = cvt_pk_bf16(z1[0], z1[1]); w.w = cvt_pk_bf16(z1[2], z1[3]);
                    *(u32x4*)(O + (size_t)(row0 + ai * HALF + m * 16) * 5120 + zc) = w; }
            return;
        }
#pragma unroll
        for (int ai = 0; ai < 2; ++ai)
#pragma unroll
            for (int m = 0; m < 4; ++m) { const int row = row0 + ai * HALF + m * 16; bf16_t* rowp = O + (size_t)row * 5120 + col0; float s = 0.f, ss = 0.f;
#pragma unroll
                for (int bj = 0; bj < 2; ++bj) { f32x4 v0 = acc[ai][bj][m][0], v1 = acc[ai][bj][m][1];
                    if (act) {
#pragma unroll
                        for (int j = 0; j < 4; ++j) { v0[j] = gelu_tanh(v0[j]); v1[j] = gelu_tanh(v1[j]); }
                    }
                    u32x4 w; w.x = cvt_pk_bf16(v0[0], v0[1]); w.y = cvt_pk_bf16(v0[2], v0[3]); w.z = cvt_pk_bf16(v1[0], v1[1]); w.w = cvt_pk_bf16(v1[2], v1[3]);
                    if (st) {
                        const float a0 = bf_lo(w.x), a1 = bf_hi(w.x), a2 = bf_lo(w.y), a3 = bf_hi(w.y), a4 = bf_lo(w.z), a5 = bf_hi(w.z), a6 = bf_lo(w.w), a7 = bf_hi(w.w);
                        s += ((a0 + a1) + (a2 + a3)) + ((a4 + a5) + (a6 + a7));
                        ss += ((a0 * a0 + a1 * a1) + (a2 * a2 + a3 * a3)) + ((a4 * a4 + a5 * a5) + (a6 * a6 + a7 * a7)); }
                    *(u32x4*)(rowp + bj * HALF) = w; }
                if (st) { s += __shfl_xor(s, 16); s += __shfl_xor(s, 32); ss += __shfl_xor(ss, 16); ss += __shfl_xor(ss, 32);
                    if (fq == 0) *(f32x2*)(stats + ((size_t)row * 16 + (u.pn - 4) * 4 + wc) * 2) = (f32x2){s, ss}; } }
    }
};
struct EpiRelu2 {
    static constexpr bool PERM = true, AFTER_DRAIN = false;
    bf16_t* O; int ldc;
    __device__ __forceinline__ void operator()(const f32x4 (&acc)[2][2][4][2], const Unit& u, int wr, int wc, int fr, int fq) const {
        const int row0 = u.pm * BM + wr * 64 + fr, col0 = u.pn * BM + wc * 32 + 8 * fq;
#pragma unroll
        for (int ai = 0; ai < 2; ++ai)
#pragma unroll
            for (int m = 0; m < 4; ++m) { bf16_t* rowp = O + (size_t)(row0 + ai * HALF + m * 16) * ldc + col0;
#pragma unroll
                for (int bj = 0; bj < 2; ++bj) { f32x4 v0 = acc[ai][bj][m][0], v1 = acc[ai][bj][m][1];
#pragma unroll
                    for (int j = 0; j < 4; ++j) { const float a = fmaxf(v0[j], 0.f), b = fmaxf(v1[j], 0.f); v0[j] = a * a; v1[j] = b * b; }
                    u32x4 w; w.x = cvt_pk_bf16(v0[0], v0[1]); w.y = cvt_pk_bf16(v0[2], v0[3]); w.z = cvt_pk_bf16(v1[0], v1[1]); w.w = cvt_pk_bf16(v1[2], v1[3]);
                    *(u32x4*)(rowp + bj * HALF) = w; } }
    }
};
struct EpiQKV {
    static constexpr bool PERM = true, AFTER_DRAIN = false;
    bf16_t* O; const float* cosT; const float* sinT;
    __device__ __forceinline__ void operator()(const f32x4 (&acc)[2][2][4][2], const Unit& u, int wr, int wc, int fr, int fq) const {
        const int row0 = u.pm * BM + wr * 64 + fr, dlo = (wc & 1) * 32 + 8 * fq, head = (u.pn & 7) * 2 + (wc >> 1);
        const bool rot = u.pn < 16; const float qs = (u.pn < 8) ? (0.08838834764831845f * 1.4426950408889634f) : 1.0f;
        bf16_t* base = O + (size_t)(u.pn >> 3) * ((size_t)T_TOK * DM) + (size_t)head * (SEQ * 128) + dlo;
#pragma unroll
        for (int ai = 0; ai < 2; ++ai)
#pragma unroll
            for (int m = 0; m < 4; ++m) { const int row = row0 + ai * HALF + m * 16, pos = row & (SEQ - 1);
                bf16_t* rowp = base + (size_t)(row >> 12) * (16 * SEQ * 128) + (size_t)pos * 128;
                f32x4 x1a = acc[ai][0][m][0], x1b = acc[ai][0][m][1], x2a = acc[ai][1][m][0], x2b = acc[ai][1][m][1];
                if (rot) { const float* cp = cosT + pos * 64 + dlo; const float* sp = sinT + pos * 64 + dlo;
                    const f32x4 ca = *(const f32x4*)cp, cb = *(const f32x4*)(cp + 4), sa = *(const f32x4*)sp, sb = *(const f32x4*)(sp + 4);
                    const f32x4 o1a = (x1a * ca - x2a * sa) * qs, o1b = (x1b * cb - x2b * sb) * qs, o2a = (x2a * ca + x1a * sa) * qs, o2b = (x2b * cb + x1b * sb) * qs;
                    x1a = o1a; x1b = o1b; x2a = o2a; x2b = o2b; }
                u32x4 w1, w2; w1.x = cvt_pk_bf16(x1a[0], x1a[1]); w1.y = cvt_pk_bf16(x1a[2], x1a[3]); w1.z = cvt_pk_bf16(x1b[0], x1b[1]); w1.w = cvt_pk_bf16(x1b[2], x1b[3]);
                w2.x = cvt_pk_bf16(x2a[0], x2a[1]); w2.y = cvt_pk_bf16(x2a[2], x2a[3]); w2.z = cvt_pk_bf16(x2b[0], x2b[1]); w2.w = cvt_pk_bf16(x2b[2], x2b[3]);
                *(u32x4*)rowp = w1; *(u32x4*)(rowp + 64) = w2; }
    }
};

template <class Epi, class Sched, bool STAMP = false>
__device__ __forceinline__ void gemm_phase(PG8_LAS unsigned char* lds, const Gemm g, const Sched& S, const Epi& E, unsigned long long* stamps) {
    int tid = threadIdx.x; asm volatile("" : "+v"(tid));
    const int wid = __builtin_amdgcn_readfirstlane(tid >> 6), lane = tid & 63, wr = wid >> 2, wc = wid & 3, fr = lane & 15, fq = lane >> 4;
    const int K = g.K, nt = K / BK;
    int ts_lo = 0, ts_hi = 0, nts = 0; const unsigned long long rt_entry = STAMP ? (unsigned long long)wall_clock64() : 0ull;
#define PG8_STAMP() do { if (STAMP && wid == 0 && nts < 64) { const unsigned long long _c = (unsigned long long)clock64(); \
        ts_lo = (lane == nts) ? (int)(unsigned)_c : ts_lo; ts_hi = (lane == nts) ? (int)(unsigned)(_c >> 32) : ts_hi; ++nts; } } while (0)
    PG8_STAMP();
    unsigned voffA[2], voffB[2];
#pragma unroll
    for (int i = 0; i < 2; ++i) { int R, C; stage_rc(tid * 16 + i * 8192, R, C); const int Rb = Epi::PERM ? ((R & ~31) + perm32(R & 31)) : R;
        voffA[i] = (unsigned)(R * K + C) * 2u; voffB[i] = (unsigned)(Rb * K + C) * 2u; }
    const size_t kstep = (size_t)(BK * 2);
    const size_t hstep = (size_t)HALF * K * 2;
    const size_t tstep = 2 * hstep;
    const unsigned ldsw = (unsigned)wid * 1024u;
    const int aoff = lds_byte(wr * 64 + fr, fq * 8), boff = lds_byte(wc * 32 + fr, fq * 8);
#define PG8_SA(b, h) (((b) * 2 + (h)) * HTB)
#define PG8_SB(b, h) ((4 + (b) * 2 + (h)) * HTB)
#define PG8_STAGE(bufoff, gbase, voff) do { _Pragma("unroll") for (int _i = 0; _i < 2; ++_i) \
        __builtin_amdgcn_global_load_lds((const unsigned*)((const char*)(gbase) + (voff)[_i]), (PG8_LAS unsigned*)(lds + (bufoff) + ldsw + _i * 8192), 16, 0, 0); } while (0)
#define PG8_LDA(dst, b, h) do { _Pragma("unroll") for (int m = 0; m < 4; ++m) _Pragma("unroll") for (int k = 0; k < 2; ++k) dst[m][k] = *(const PG8_LAS bf16x8*)(lds + PG8_SA(b, h) + aoff + m * 2048 + k * 1024); } while (0)
#define PG8_LDB(dst, b, h) do { _Pragma("unroll") for (int n = 0; n < 2; ++n) _Pragma("unroll") for (int k = 0; k < 2; ++k) dst[n][k] = *(const PG8_LAS bf16x8*)(lds + PG8_SB(b, h) + boff + n * 2048 + k * 1024); } while (0)
#define PG8_MMA(ai, bj, At, Bt) do { __builtin_amdgcn_s_setprio(1); _Pragma("unroll") for (int m = 0; m < 4; ++m) _Pragma("unroll") for (int n = 0; n < 2; ++n) _Pragma("unroll") for (int k = 0; k < 2; ++k) \
        acc[ai][bj][m][n] = __builtin_amdgcn_mfma_f32_16x16x32_bf16(Bt[n][k], At[m][k], acc[ai][bj][m][n], 0, 0, 0); __builtin_amdgcn_s_setprio(0); } while (0)
#define PG8_WAIT_V(n) asm volatile("s_waitcnt vmcnt(" #n ")" ::: "memory")
#define PG8_WAIT_L(n) asm volatile("s_waitcnt lgkmcnt(" #n ")" ::: "memory")
#define PG8_BAR __builtin_amdgcn_s_barrier()
#define PG8_SCHED __builtin_amdgcn_sched_barrier(0)
    Unit cur, nxt; int ui = 0;
    if (!S.next(0, cur)) return;
    f32x4 acc[2][2][4][2];
#pragma unroll
    for (int a = 0; a < 2; ++a)
#pragma unroll
        for (int b = 0; b < 2; ++b)
#pragma unroll
            for (int m = 0; m < 4; ++m)
#pragma unroll
                for (int n = 0; n < 2; ++n) acc[a][b][m][n] = (f32x4){0.f, 0.f, 0.f, 0.f};
    bf16x8 At[4][2], B0[2][2], B1[2][2];
    const char* cA = (const char*)g.A + (size_t)cur.pm * tstep; const char* cB = (const char*)g.Bt + (size_t)cur.pn * tstep;
    S.a_ready(cur);
    PG8_STAGE(PG8_SB(0, 0), cB, voffB); PG8_STAGE(PG8_SA(0, 0), cA, voffA); PG8_STAGE(PG8_SB(0, 1), cB + hstep, voffB); PG8_STAGE(PG8_SA(0, 1), cA + hstep, voffA);
    if (wr == 1) PG8_BAR;
    PG8_WAIT_V(4); PG8_BAR;
    PG8_STAGE(PG8_SB(1, 0), cB + kstep, voffB); PG8_STAGE(PG8_SA(1, 0), cA + kstep, voffA); PG8_STAGE(PG8_SB(1, 1), cB + hstep + kstep, voffB);
    PG8_WAIT_V(6); PG8_BAR;
    PG8_STAMP();
    for (;;) {
        const bool has_next = S.next(ui + 1, nxt);
        const char* nA = has_next ? (const char*)g.A + (size_t)nxt.pm * tstep : cA; const char* nB = has_next ? (const char*)g.Bt + (size_t)nxt.pn * tstep : cB;
        for (int t = 0; t < nt; t += 2) {
            const bool last = (t == nt - 2);
            const char* a1 = cA + (size_t)(t + 1) * kstep;
            const char* a2 = last ? nA : cA + (size_t)(t + 2) * kstep; const char* b2 = last ? nB : cB + (size_t)(t + 2) * kstep;
            const char* a3 = a2 + kstep; const char* b3 = b2 + kstep;
            if (last && has_next) S.a_ready(nxt);
            PG8_LDB(B0, 0, 0); PG8_SCHED; PG8_LDA(At, 0, 0); PG8_STAGE(PG8_SA(1, 1), a1 + hstep, voffA);
            PG8_WAIT_L(8); PG8_BAR; PG8_WAIT_L(0); PG8_MMA(0, 0, At, B0); PG8_BAR; PG8_SCHED;
            PG8_LDB(B1, 0, 1); PG8_STAGE(PG8_SB(0, 0), b2, voffB);
            PG8_BAR; PG8_WAIT_L(0); PG8_MMA(0, 1, At, B1); PG8_BAR;
            PG8_LDA(At, 0, 1); PG8_STAGE(PG8_SA(0, 0), a2, voffA);
            PG8_BAR; PG8_WAIT_L(0); PG8_MMA(1, 0, At, B0); PG8_BAR; PG8_SCHED;
            PG8_STAGE(PG8_SB(0, 1), b2 + hstep, voffB);
            PG8_WAIT_V(6); PG8_BAR; PG8_MMA(1, 1, At, B1); PG8_BAR;
            PG8_LDB(B0, 1, 0); PG8_SCHED; PG8_LDA(At, 1, 0); PG8_STAGE(PG8_SA(0, 1), a2 + hstep, voffA);
            PG8_WAIT_L(8); PG8_BAR; PG8_WAIT_L(0); PG8_MMA(0, 0, At, B0); PG8_BAR; PG8_SCHED;
            PG8_LDB(B1, 1, 1); PG8_STAGE(PG8_SB(1, 0), b3, voffB);
            PG8_BAR; PG8_WAIT_L(0); PG8_MMA(0, 1, At, B1); PG8_BAR;
            PG8_LDA(At, 1, 1); PG8_STAGE(PG8_SA(1, 0), a3, voffA);
            PG8_BAR; PG8_WAIT_L(0); PG8_MMA(1, 0, At, B0); PG8_BAR; PG8_SCHED;
            PG8_STAGE(PG8_SB(1, 1), b3 + hstep, voffB);
            PG8_WAIT_V(6); PG8_BAR; PG8_MMA(1, 1, At, B1); PG8_BAR;
        }
        PG8_STAMP();
        if constexpr (!Epi::AFTER_DRAIN) { E(acc, cur, wr, wc, fr, fq); S.done(cur); }
        PG8_STAMP();
        if (!has_next) break;
#pragma unroll
        for (int a = 0; a < 2; ++a)
#pragma unroll
            for (int b = 0; b < 2; ++b)
#pragma unroll
                for (int m = 0; m < 4; ++m)
#pragma unroll
                    for (int n = 0; n < 2; ++n) acc[a][b][m][n] = (f32x4){0.f, 0.f, 0.f, 0.f};
        cur = nxt; cA = nA; cB = nB; ++ui;
    }
    PG8_WAIT_V(0);
    if (wr == 0) PG8_BAR;
    PG8_BAR;
    if constexpr (Epi::AFTER_DRAIN) { E.fused(acc, cur, wr, wc, fr, fq, lds, wid, lane); S.done(cur); }
    PG8_STAMP();
    if (STAMP && wid == 0) { stamps[lane] = lane < nts ? (((unsigned long long)(unsigned)ts_hi << 32) | (unsigned)ts_lo) : 0ull;
        if (lane == 62) stamps[62] = rt_entry; if (lane == 63) stamps[63] = (unsigned long long)wall_clock64(); }
#undef PG8_STAMP
#undef PG8_SA
#undef PG8_SB
#undef PG8_STAGE
#undef PG8_LDA
#undef PG8_LDB
#undef PG8_MMA
#undef PG8_WAIT_V
#undef PG8_WAIT_L
#undef PG8_BAR
#undef PG8_SCHED
}}

#define XB_TMO      128
#define XB_XCNT(j)  (256  + 64 * (j))
#define XB_XSUB(j)  (1280 + 64 * (j))
#define XB_XGEN(j)  (2304 + 64 * (j))
#define XB_TOP      3328
#define XB_TOPGEN   3392
#define XCD_BAR_WORDS 3456
#define XB_SPIN_CAP (1u << 22)

__device__ __forceinline__ unsigned xb_ld(unsigned* p)              { return __hip_atomic_load(p, __ATOMIC_RELAXED, __HIP_MEMORY_SCOPE_AGENT); }
__device__ __forceinline__ unsigned xb_add(unsigned* p, unsigned v) { return __hip_atomic_fetch_add(p, v, __ATOMIC_RELAXED, __HIP_MEMORY_SCOPE_AGENT); }
__device__ __forceinline__ unsigned xb_xcc_id() { return (unsigned)__builtin_amdgcn_s_getreg((3 << 11) | 20) & 0xFu; }
#define XB_SPIN(cond, bar) do { unsigned _sp = 0; while (cond) { __builtin_amdgcn_s_sleep(1); \
    if ((++_sp & 255u) == 0u) { if (xb_ld(&(bar)[XB_TMO])) break; if (_sp > XB_SPIN_CAP) { atomicAdd(&(bar)[XB_TMO], 1u); break; } } } } while (0)

struct XcdBarrier {
    unsigned* bar; unsigned x;
    volatile LAS unsigned* st;
};

__device__ __forceinline__ XcdBarrier xcd_barrier_post(unsigned* bar, volatile LAS unsigned* st) {
    XcdBarrier b; b.bar = bar; b.x = xb_xcc_id(); b.st = st;
    if (threadIdx.x == 0) (void)xb_add(&bar[XB_XCNT(b.x)], 1u);
    return b;
}
__device__ __forceinline__ void xcd_barrier_complete(unsigned* bar, unsigned x, unsigned& nloc, unsigned& nx) {
    const unsigned G = gridDim.x * gridDim.y * gridDim.z;
    unsigned sum, cnt, mine, sp = 0u;
    for (;;) {
        sum = 0u; cnt = 0u; mine = 0u;
#pragma unroll
        for (unsigned j = 0; j < 16; ++j) { const unsigned c = xb_ld(&bar[XB_XCNT(j)]); sum += c; cnt += (c > 0u) ? 1u : 0u; mine = (j == x) ? c : mine; }
        if (sum == G) break;
        __builtin_amdgcn_s_sleep(1);
        if ((++sp & 255u) == 0u) { if (xb_ld(&bar[XB_TMO])) break; if (sp > XB_SPIN_CAP) { atomicAdd(&bar[XB_TMO], 1u); break; } }
    }
    nloc = mine > 0u ? mine : 1u; nx = cnt > 0u ? cnt : 1u;
}

__device__ __forceinline__ void xcd_barrier(const XcdBarrier& b) {
    asm volatile("s_waitcnt vmcnt(0)" ::: "memory");
    __syncthreads();
    if (threadIdx.x == 0) {
        unsigned* bar = b.bar;
        __builtin_amdgcn_s_waitcnt(0);
        unsigned nloc = b.st[0], nx = b.st[1];
        if (nloc == 0u) { xcd_barrier_complete(bar, b.x, nloc, nx); b.st[0] = nloc; b.st[1] = nx; }
        const unsigned old = xb_add(&bar[XB_XSUB(b.x)], 1u);
        const unsigned gen = old / nloc;
        if (old + 1u == (gen + 1u) * nloc) {
            __builtin_amdgcn_fence(__ATOMIC_RELEASE, "agent");
            asm volatile("s_waitcnt vmcnt(0)" ::: "memory");
            const unsigned og = xb_add(&bar[XB_TOP], 1u);
            const unsigned tg = og / nx;
            if (og + 1u == (tg + 1u) * nx) xb_add(&bar[XB_TOPGEN], 1u);
            else XB_SPIN(xb_ld(&bar[XB_TOPGEN]) == tg, bar);
            __builtin_amdgcn_fence(__ATOMIC_ACQUIRE, "agent");
            xb_add(&bar[XB_XGEN(b.x)], 1u);
            asm volatile("s_waitcnt vmcnt(0)" ::: "memory");
        } else {
            XB_SPIN(xb_ld(&bar[XB_XGEN(b.x)]) == gen, bar);
            __builtin_amdgcn_fence(__ATOMIC_ACQUIRE, "agent");
            asm volatile("s_waitcnt vmcnt(0)" ::: "memory");
        }
    }
    __syncthreads();
}

constexpr size_t SZ_WIN = (size_t)2 * 5120 * 2048 * 2, SZ_W22 = (size_t)2 * 2048 * 2048 * 2, SZ_WQKV = (size_t)2 * 6144 * 2048 * 2, SZ_WUP = (size_t)4 * 8192 * 2048 * 2;
constexpr size_t OFF_WIN = 0, OFF_WOUT = OFF_WIN + SZ_WIN, OFF_WQKV = OFF_WOUT + SZ_W22, OFF_WO = OFF_WQKV + SZ_WQKV, OFF_WUP = OFF_WO + SZ_W22, OFF_WDOWN = OFF_WUP + SZ_WUP;
constexpr size_t OFF_WSP = OFF_WDOWN + SZ_WUP;
constexpr size_t OFF_ROPE = OFF_WSP + (size_t)2 * 8 * 128 * 128 * 2;
constexpr size_t OFF_STATS = OFF_ROPE + (size_t)2 * 4096 * 64 * 4;
constexpr size_t OFF_LSE = OFF_STATS + (size_t)T_TOK * 16 * 8;
constexpr size_t OFF_HN = OFF_LSE + (size_t)3 * T_TOK * 16 * 4;
constexpr size_t OFF_GOUT = OFF_HN + (size_t)T_TOK * DM * 2;
constexpr size_t OFF_MO = OFF_GOUT + (size_t)T_TOK * DM * 4;
constexpr size_t OFF_BIG = OFF_MO + (size_t)T_TOK * DM * 2;
constexpr size_t OFF_BAR = OFF_BIG + (size_t)T_TOK * 8192 * 2;
constexpr size_t BAR_BYTES = 16384;
constexpr size_t OFF_RB = OFF_BAR + BAR_BYTES;
constexpr size_t WS_END = OFF_RB + (size_t)T_TOK * 4;
constexpr int LDS_MAIN = 143360;
constexpr int LDS_XB = LDS_MAIN + 16384 + 1024;
constexpr int LDS_BYTES = LDS_XB + 16;
#define GSYNC() xcd_barrier(xb)

struct Params {
    const float* x; const float* n_mix_pre; const float* n_mix_post; const float* n_mlp_pre; const float* n_mlp_post;
    const float* w_in; const float* w_sp; const float* b_sp; const float* conv_w; const float* w_out; const float* w_qkv; const float* w_o; const float* w_up; const float* w_down;
    float* out; unsigned char* ws;
};

__device__ __forceinline__ void transpose_cvt(LAS unsigned char* lds, const float* __restrict__ W, bf16_t* __restrict__ Wt, int L, int K, int N, int perm) {
    int tid = threadIdx.x; asm volatile("" : "+v"(tid));
    const int tk = K >> 7, tn = N >> 6, per = tk * tn, ntile = L * per;
    const int kp0 = tid >> 4, c4 = tid & 15;
    f32x4 ra[2], rb[2];
#define TR_LOAD(t_) do { const int l_ = (t_) / per, r_ = (t_) - l_ * per, kt_ = r_ / tn, nt_ = r_ - kt_ * tn; const float* src_ = W + ((size_t)l_ * K + (size_t)kt_ * 128) * N + nt_ * 64 + 4 * c4; \
        _Pragma("unroll") for (int i_ = 0; i_ < 2; ++i_) { const int kp_ = kp0 + 32 * i_; ra[i_] = *(const f32x4*)(src_ + (size_t)(2 * kp_) * N); rb[i_] = *(const f32x4*)(src_ + (size_t)(2 * kp_ + 1) * N); } } while (0)
    int t = blockIdx.x;
    if (t < ntile) TR_LOAD(t);
    for (; t < ntile; t += gridDim.x) {
        const int l = t / per, r = t - l * per, kt = r / tn, nt = r - kt * tn;
        __syncthreads();
#pragma unroll
        for (int i = 0; i < 2; ++i) { const int kp = kp0 + 32 * i;
#pragma unroll
            for (int j = 0; j < 4; ++j) *(LAS unsigned*)(lds + (4 * c4 + j) * 272 + kp * 4) = cvt_pk_bf16(ra[i][j], rb[i][j]); }
        if (t + (int)gridDim.x < ntile) TR_LOAD(t + (int)gridDim.x);
        __syncthreads();
#pragma unroll
        for (int i = 0; i < 2; ++i) { const int idx = tid + 512 * i, n = idx >> 4, kc = idx & 15;
            const u32x4 v = *(const LAS u32x4*)(lds + n * 272 + kc * 16);
            int ncol = nt * 64 + n;
            if (perm == 1) { const int nl = ncol & 255, hl = nl >> 7, dd = nl & 127; ncol = (ncol & ~255) + (dd >> 6) * 128 + hl * 64 + (dd & 63); }
            if (perm == 2 && ncol >= 3072) { const int q = ncol - 3072, c = q & 1023; ncol = 3072 + (c >> 7) * 256 + (q >> 10) * 128 + (c & 127); }
            *(u32x4*)(Wt + ((size_t)l * N + ncol) * K + kt * 128 + kc * 8) = v; }
    }
#undef TR_LOAD
}

__device__ __forceinline__ void norm_phase_b(const bf16_t* __restrict__ gin, bf16_t* hn, float* rbuf, float* __restrict__ outf, const float* __restrict__ gprev, const float* __restrict__ gpost, const float* __restrict__ gpre, int mode) {
    int tid = threadIdx.x; asm volatile("" : "+v"(tid));
    const int lane = tid & 63, w = tid >> 6;
    for (int row = blockIdx.x * 8 + w; row < T_TOK; row += gridDim.x * 8) {
        f32x4 ha[4], hc[4]; u32x4 gv[4]; bf16_t* hp = hn + (size_t)row * DM + 8 * lane; const bf16_t* gp = gin + (size_t)row * DM + 8 * lane; float ss = 0.f;
        const float rinv = __builtin_amdgcn_rcpf(rbuf[row]);
#pragma unroll
        for (int i = 0; i < 4; ++i) { const u32x4 hw = *(const u32x4*)(hp + 512 * i); gv[i] = *(const u32x4*)(gp + 512 * i);
            const f32x4 pa = *(const f32x4*)(gprev + 8 * lane + 512 * i), pb = *(const f32x4*)(gprev + 8 * lane + 512 * i + 4);
            ha[i] = ((f32x4){bf_lo(hw.x), bf_hi(hw.x), bf_lo(hw.y), bf_hi(hw.y)} * rinv) * (f32x4){__builtin_amdgcn_rcpf(pa[0]), __builtin_amdgcn_rcpf(pa[1]), __builtin_amdgcn_rcpf(pa[2]), __builtin_amdgcn_rcpf(pa[3])};
            hc[i] = ((f32x4){bf_lo(hw.z), bf_hi(hw.z), bf_lo(hw.w), bf_hi(hw.w)} * rinv) * (f32x4){__builtin_amdgcn_rcpf(pb[0]), __builtin_amdgcn_rcpf(pb[1]), __builtin_amdgcn_rcpf(pb[2]), __builtin_amdgcn_rcpf(pb[3])};
            const float a0 = bf_lo(gv[i].x), a1 = bf_hi(gv[i].x), a2 = bf_lo(gv[i].y), a3 = bf_hi(gv[i].y), a4 = bf_lo(gv[i].z), a5 = bf_hi(gv[i].z), a6 = bf_lo(gv[i].w), a7 = bf_hi(gv[i].w);
            ss += ((a0 * a0 + a1 * a1) + (a2 * a2 + a3 * a3)) + ((a4 * a4 + a5 * a5) + (a6 * a6 + a7 * a7)); }
#pragma unroll
        for (int o = 1; o < 64; o <<= 1) ss += __shfl_xor(ss, o);
        const float r = 1.0f / sqrtf(ss * (1.0f / DM) + 1e-6f);
        float ss2 = 0.f;
#pragma unroll
        for (int i = 0; i < 4; ++i) { const f32x4 ga = *(const f32x4*)(gpost + 8 * lane + 512 * i), gb = *(const f32x4*)(gpost + 8 * lane + 512 * i + 4);
            const f32x4 xa = (f32x4){bf_lo(gv[i].x), bf_hi(gv[i].x), bf_lo(gv[i].y), bf_hi(gv[i].y)}, xb = (f32x4){bf_lo(gv[i].z), bf_hi(gv[i].z), bf_lo(gv[i].w), bf_hi(gv[i].w)};
            ha[i] = ha[i] + (xa * r) * ga; hc[i] = hc[i] + (xb * r) * gb;
            ss2 += ((ha[i][0] * ha[i][0] + ha[i][1] * ha[i][1]) + (ha[i][2] * ha[i][2] + ha[i][3] * ha[i][3])) + ((hc[i][0] * hc[i][0] + hc[i][1] * hc[i][1]) + (hc[i][2] * hc[i][2] + hc[i][3] * hc[i][3])); }
        if (mode == 2) { float* op = outf + (size_t)row * DM + 8 * lane;
#pragma unroll
            for (int i = 0; i < 4; ++i) { *(f32x4*)(op + 512 * i) = ha[i]; *(f32x4*)(op + 512 * i + 4) = hc[i]; }
        } else {
#pragma unroll
            for (int o = 1; o < 64; o <<= 1) ss2 += __shfl_xor(ss2, o);
            const float r2 = 1.0f / sqrtf(ss2 * (1.0f / DM) + 1e-6f);
            if (lane == 0) rbuf[row] = r2;
#pragma unroll
            for (int i = 0; i < 4; ++i) { const f32x4 ga = *(const f32x4*)(gpre + 8 * lane + 512 * i), gb = *(const f32x4*)(gpre + 8 * lane + 512 * i + 4);
                const f32x4 ya = (ha[i] * r2) * ga, yb = (hc[i] * r2) * gb;
                u32x4 wv; wv.x = cvt_pk_bf16(ya[0], ya[1]); wv.y = cvt_pk_bf16(ya[2], ya[3]); wv.z = cvt_pk_bf16(yb[0], yb[1]); wv.w = cvt_pk_bf16(yb[2], yb[3]); *(u32x4*)(hp + 512 * i) = wv; }
        }
    }
}

__device__ __forceinline__ void init_phase(const float* __restrict__ x, float* __restrict__ rbuf, const float* __restrict__ gpre, bf16_t* __restrict__ hn) {
    int tid = threadIdx.x; asm volatile("" : "+v"(tid));
    const int lane = tid & 63, w = tid >> 6;
    for (int row = blockIdx.x * 8 + w; row < T_TOK; row += gridDim.x * 8) {
        f32x4 ha[4], hc[4]; const float* hp = x + (size_t)row * DM + 8 * lane; float ss = 0.f;
#pragma unroll
        for (int i = 0; i < 4; ++i) { ha[i] = *(const f32x4*)(hp + 512 * i); hc[i] = *(const f32x4*)(hp + 512 * i + 4);
            ss += ((ha[i][0] * ha[i][0] + ha[i][1] * ha[i][1]) + (ha[i][2] * ha[i][2] + ha[i][3] * ha[i][3])) + ((hc[i][0] * hc[i][0] + hc[i][1] * hc[i][1]) + (hc[i][2] * hc[i][2] + hc[i][3] * hc[i][3])); }
#pragma unroll
        for (int o = 1; o < 64; o <<= 1) ss += __shfl_xor(ss, o);
        const float r = 1.0f / sqrtf(ss * (1.0f / DM) + 1e-6f);
        if (lane == 0) rbuf[row] = r;
        bf16_t* np = hn + (size_t)row * DM + 8 * lane;
#pragma unroll
        for (int i = 0; i < 4; ++i) { const f32x4 ga = *(const f32x4*)(gpre + 8 * lane + 512 * i), gb = *(const f32x4*)(gpre + 8 * lane + 512 * i + 4);
            const f32x4 ya = (ha[i] * r) * ga, yb = (hc[i] * r) * gb;
            u32x4 wv; wv.x = cvt_pk_bf16(ya[0], ya[1]); wv.y = cvt_pk_bf16(ya[2], ya[3]); wv.z = cvt_pk_bf16(yb[0], yb[1]); wv.w = cvt_pk_bf16(yb[2], yb[3]); *(u32x4*)(np + 512 * i) = wv; }
    }
}

__device__ __forceinline__ void tr8(unsigned alo, unsigned ahi, s16x4 (&lo)[4], s16x4 (&hi)[4]) {
    asm volatile("ds_read_b64_tr_b16 %0, %8\n\tds_read_b64_tr_b16 %1, %8 offset:32\n\tds_read_b64_tr_b16 %2, %8 offset:64\n\tds_read_b64_tr_b16 %3, %8 offset:96\n\t"
                 "ds_read_b64_tr_b16 %4, %9\n\tds_read_b64_tr_b16 %5, %9 offset:32\n\tds_read_b64_tr_b16 %6, %9 offset:64\n\tds_read_b64_tr_b16 %7, %9 offset:96\n\t"
                 "s_waitcnt lgkmcnt(0)"
                 : "=&v"(lo[0]), "=&v"(lo[1]), "=&v"(lo[2]), "=&v"(lo[3]), "=&v"(hi[0]), "=&v"(hi[1]), "=&v"(hi[2]), "=&v"(hi[3]) : "v"(alo), "v"(ahi) : "memory");
}
__device__ __forceinline__ bf16x8 cat4(s16x4 a, s16x4 b) { return (bf16x8){a[0], a[1], a[2], a[3], b[0], b[1], b[2], b[3]}; }
#define MFMA16(a, b, c) __builtin_amdgcn_mfma_f32_16x16x32_bf16((a), (b), (c), 0, 0, 0)

__device__ __forceinline__ void mixer_phase(LAS unsigned char* lds, unsigned ldsb, const bf16_t* __restrict__ proj, const float* __restrict__ stats, const bf16_t* __restrict__ Wc,
                                            const float* __restrict__ b_s, const float* __restrict__ conv_w, bf16_t* __restrict__ mo) {
    constexpr int VP = 288;
    int tid = threadIdx.x; asm volatile("" : "+v"(tid));
    const int w = __builtin_amdgcn_readfirstlane(tid >> 6), lane = tid & 63, j = lane & 15, fq = lane >> 4;
    LAS float* mu_s = (LAS float*)(lds + 128 * VP); LAS float* rs_s = mu_s + 128;
    const bool xdeal = (gridDim.x == 256);
    int last_ch = -1;
    for (int it0 = blockIdx.x, ii = 0; it0 < 1024; it0 += gridDim.x, ++ii) {
        const int item = xdeal ? (128 * ((int)blockIdx.x & 7) + 4 * ((int)blockIdx.x >> 3) + ii) : it0;
        const int ch = item >> 3, g = item & 7, tok0 = ch * 128;
        u32x4 cgb[4], cz0[4], cz1[4], cz2[4];
#pragma unroll
        for (int i = 0; i < 4; ++i) { const int c = tid + 512 * i, row = c >> 4, ck = c & 15, cB = g * 128 + ck * 8, tok = tok0 + row, pos = tok & (SEQ - 1);
            const bf16_t* pp = proj + (size_t)tok * 5120 + cB;
            cgb[i] = *(const u32x4*)(pp + 2048); cz0[i] = *(const u32x4*)(pp + 3072);
            cz1[i] = (u32x4){0, 0, 0, 0}; cz2[i] = cz1[i];
            if (pos >= 1) cz1[i] = *(const u32x4*)(pp - 5120 + 3072);
            if (pos >= 2) cz2[i] = *(const u32x4*)(pp - 10240 + 3072); }
        __syncthreads();
        if (ch != last_ch) {
        last_ch = ch;
        if (tid < 128) { const f32x2* sp = (const f32x2*)(stats + (size_t)(tok0 + tid) * 32); float s = 0.f, ss = 0.f;
#pragma unroll
            for (int i = 0; i < 16; ++i) { const f32x2 v = sp[i]; s += v.x; ss += v.y; }
            const float mu = s * (1.0f / 1024.0f), var = fmaxf(ss * (1.0f / 1024.0f) - mu * mu, 0.f);
            mu_s[tid] = mu; rs_s[tid] = 1.0f / sqrtf(var + 1e-5f); }
        __syncthreads();
        }
#pragma unroll
        for (int i = 0; i < 4; ++i) { const int c = tid + 512 * i, row = c >> 4, ck = c & 15;
            const u32x4 raw = *(const u32x4*)(proj + (size_t)(tok0 + row) * 5120 + 1024 + g * 128 + ck * 8);
            const float mu = mu_s[row], rs = rs_s[row]; u32x4 o;
            o.x = cvt_pk_bf16((bf_lo(raw.x) - mu) * rs, (bf_hi(raw.x) - mu) * rs); o.y = cvt_pk_bf16((bf_lo(raw.y) - mu) * rs, (bf_hi(raw.y) - mu) * rs);
            o.z = cvt_pk_bf16((bf_lo(raw.z) - mu) * rs, (bf_hi(raw.z) - mu) * rs); o.w = cvt_pk_bf16((bf_lo(raw.w) - mu) * rs, (bf_hi(raw.w) - mu) * rs);
            *(LAS u32x4*)(lds + row * VP + ck * 16) = o; }
        __syncthreads();
        const int t = 16 * w + j;
        const bf16_t* wp = Wc + (size_t)(g * 128 + t) * 128 + 4 * fq;
        const float bias = b_s[g * 128 + t];
        u32x2 aup[8];
        { const bf16_t* up = proj + (size_t)(tok0 + t) * 5120 + g * 128 + 4 * fq;
#pragma unroll
          for (int c = 0; c < 8; ++c) aup[c] = *(const u32x2*)(up + 16 * c); }
        f32x4 acc[8];
#pragma unroll
        for (int i = 0; i < 8; ++i) acc[i] = (f32x4){0.f, 0.f, 0.f, 0.f};
        const unsigned abase = ldsb + (unsigned)((4 * fq + (j >> 2)) * VP + (j & 3) * 8);
#pragma unroll
        for (int ks = 0; ks < 4; ++ks) {
            if (ks <= (w >> 1)) {
                const s16x4 b0 = *(const s16x4*)(wp + 32 * ks), b1 = *(const s16x4*)(wp + 32 * ks + 16);
                const bf16x8 b = cat4(b0, b1);
                s16x4 lo[4], hi[4];
                const unsigned alo = abase + (unsigned)(32 * ks * VP), ahi = alo + 16 * VP;
                tr8(alo, ahi, lo, hi);
#pragma unroll
                for (int c = 0; c < 4; ++c) acc[c] = MFMA16(cat4(lo[c], hi[c]), b, acc[c]);
                tr8(alo + 128, ahi + 128, lo, hi);
#pragma unroll
                for (int c = 0; c < 4; ++c) acc[4 + c] = MFMA16(cat4(lo[c], hi[c]), b, acc[4 + c]);
            }
        }
        {
            bf16_t* op = mo + (size_t)(tok0 + t) * DM + g * 128 + 4 * fq;
#pragma unroll
            for (int c = 0; c < 8; ++c) { const u32x2 au = aup[c]; u32x2 o;
                o.x = cvt_pk_bf16(bf_lo(au.x) * (acc[c][0] + bias), bf_hi(au.x) * (acc[c][1] + bias));
                o.y = cvt_pk_bf16(bf_lo(au.y) * (acc[c][2] + bias), bf_hi(au.y) * (acc[c][3] + bias));
                *(u32x2*)(op + 16 * c) = o; }
        }
#pragma unroll
        for (int i = 0; i < 4; ++i) { const int c = tid + 512 * i, row = c >> 4, ck = c & 15, cB = g * 128 + ck * 8, tok = tok0 + row;
            const u32x4 gb = cgb[i], z0 = cz0[i], z1 = cz1[i], z2 = cz2[i];
            const f32x4 w0a = *(const f32x4*)(conv_w + cB), w0b = *(const f32x4*)(conv_w + cB + 4);
            const f32x4 w1a = *(const f32x4*)(conv_w + 1024 + cB), w1b = *(const f32x4*)(conv_w + 1024 + cB + 4);
            const f32x4 w2a = *(const f32x4*)(conv_w + 2048 + cB), w2b = *(const f32x4*)(conv_w + 2048 + cB + 4);
            const unsigned gbw[4] = {gb.x, gb.y, gb.z, gb.w}, z0w[4] = {z0.x, z0.y, z0.z, z0.w}, z1w[4] = {z1.x, z1.y, z1.z, z1.w}, z2w[4] = {z2.x, z2.y, z2.z, z2.w};
            const float wt0[8] = {w0a[0], w0a[1], w0a[2], w0a[3], w0b[0], w0b[1], w0b[2], w0b[3]}, wt1[8] = {w1a[0], w1a[1], w1a[2], w1a[3], w1b[0], w1b[1], w1b[2], w1b[3]},
                        wt2[8] = {w2a[0], w2a[1], w2a[2], w2a[3], w2b[0], w2b[1], w2b[2], w2b[3]};
            unsigned ow[4];
#pragma unroll
            for (int q = 0; q < 4; ++q) {
                const float ylo = wt0[2 * q] * bf_lo(z2w[q]) + wt1[2 * q] * bf_lo(z1w[q]) + wt2[2 * q] * bf_lo(z0w[q]);
                const float yhi = wt0[2 * q + 1] * bf_hi(z2w[q]) + wt1[2 * q + 1] * bf_hi(z1w[q]) + wt2[2 * q + 1] * bf_hi(z0w[q]);
                ow[q] = cvt_pk_bf16(bf_lo(gbw[q]) * ylo, bf_hi(gbw[q]) * yhi); }
            *(u32x4*)(mo + (size_t)tok * DM + 1024 + cB) = (u32x4){ow[0], ow[1], ow[2], ow[3]}; }
    }
}

__device__ __forceinline__ void attn_phase(LAS unsigned char* lds, unsigned ldsb, const bf16_t* __restrict__ qkv, bf16_t* __restrict__ part_o, float* __restrict__ lse, bf16_t* __restrict__ mo, const int stage) {
    constexpr int KP = 272, VP = 288, VOFF = 256 * KP;
    int tid = threadIdx.x; asm volatile("" : "+v"(tid));
    const int w = __builtin_amdgcn_readfirstlane(tid >> 6), lane = tid & 63, j = lane & 15, fq = lane >> 4;
    __syncthreads();
    for (int o = tid * 16; o < LDS_MAIN; o += 512 * 16) *(LAS u32x4*)(lds + o) = (u32x4){0u, 0u, 0u, 0u};
    const int nitems = stage ? 256 : 512;
    const int srow = tid >> 4, sck = tid & 15;
    for (int item = blockIdx.x; item < nitems; item += gridDim.x) {
        const int h = (item >> 2) & 15, b = (item >> 6) & 3, lowq = item & 3;
        int dsh, rbase, nbase, pbr; bool seq2;
        if (stage) { dsh = 0; rbase = 0; nbase = 8 * lowq; seq2 = false; pbr = 0; }
        else if (item < 256) { dsh = 2; rbase = lowq; nbase = 0; seq2 = false; pbr = 0; }
        else { dsh = 4; rbase = 4 * lowq; nbase = 0; seq2 = true; pbr = 1; }
        const bf16_t* qh = qkv + (size_t)(b * 16 + h) * (SEQ * 128);
        u32x4 kreg[4], vreg[4];
#define ATT_LOAD(r_, n_) do { _Pragma("unroll") for (int i_ = 0; i_ < 4; ++i_) { const bf16_t* p_ = qh + (size_t)((r_) + ((128 * (n_) + srow + 32 * i_) << dsh)) * 128 + sck * 8; \
            kreg[i_] = *(const u32x4*)(p_ + (size_t)T_TOK * DM); vreg[i_] = *(const u32x4*)(p_ + (size_t)2 * T_TOK * DM); } } while (0)
#define ATT_STORE(slot_) do { _Pragma("unroll") for (int i_ = 0; i_ < 4; ++i_) { const int row_ = (slot_) * 128 + srow + 32 * i_; \
            *(LAS u32x4*)(lds + row_ * KP + sck * 16) = kreg[i_]; *(LAS u32x4*)(lds + VOFF + row_ * VP + sck * 16) = vreg[i_]; } } while (0)
        __syncthreads();
        bf16x8 qf[4], qn[4];
#define ATT_QLOAD(dst_, r_, n_) do { const bf16_t* qp_ = qh + (size_t)((r_) + ((128 * (n_) + 16 * w + j) << dsh)) * 128 + 8 * fq; \
            _Pragma("unroll") for (int ks_ = 0; ks_ < 4; ++ks_) dst_[ks_] = *(const bf16x8*)(qp_ + 32 * ks_); } while (0)
        { if (stage && nbase > 0) { ATT_LOAD(rbase, nbase - 1); ATT_STORE(1); }
          ATT_LOAD(rbase, nbase); ATT_QLOAD(qf, rbase, nbase); ATT_STORE(0); }
        __syncthreads();
        for (int t = 0; t < 8; ++t) {
            const int n = seq2 ? (t & 1) : nbase + t;
            const int rr = rbase + (seq2 ? (t >> 1) : 0);
            if (t < 7) { const int t1 = t + 1; const int n1 = seq2 ? (t1 & 1) : nbase + t1; const int rr1 = rbase + (seq2 ? (t1 >> 1) : 0); ATT_LOAD(rr1, n1); ATT_QLOAD(qn, rr1, n1); }
            const int f8 = (t & 1) ? 0 : 8;
            const int sq0 = rr + ((128 * n + 16 * w) << dsh);
            const size_t tok0 = (size_t)b * SEQ + sq0;
            const int rq = lane >> 3, rc = lane & 7;
            u32x4 px1[2][2], px2[2][2]; float pl1 = 0.f, pl2 = 0.f;
            if (stage) { const bf16_t* p1 = part_o + tok0 * DM + h * 128 + rc * 8; const bf16_t* p2 = p1 + (size_t)T_TOK * DM;
#pragma unroll
                for (int hh = 0; hh < 2; ++hh)
#pragma unroll
                    for (int it = 0; it < 2; ++it) { const int q = 8 * it + rq; px1[hh][it] = *(const u32x4*)(p1 + (size_t)q * DM + hh * 64); px2[hh][it] = *(const u32x4*)(p2 + (size_t)q * DM + hh * 64); }
                pl1 = lse[(tok0 + j) * 16 + h]; pl2 = lse[((size_t)T_TOK + tok0 + j) * 16 + h]; }
            f32x4 s[9];
#pragma unroll
            for (int i = 0; i < 9; ++i) { s[i] = (f32x4){0.f, 0.f, 0.f, 0.f};
                const LAS unsigned char* ka = lds + (16 * ((w + i) ^ f8) + j) * KP + 16 * fq;
#pragma unroll
                for (int ks = 0; ks < 4; ++ks) s[i] = MFMA16(*(const LAS bf16x8*)(ka + 64 * ks), qf[ks], s[i]); }
            const float NEG = -__builtin_inff();
            float m = NEG;
#pragma unroll
            for (int i = 0; i < 9; ++i)
#pragma unroll
                for (int e = 0; e < 4; ++e) { const int ki = 16 * (w + i) + 4 * fq + e, step = j + 128 - 16 * i - 4 * fq - e;
                    const bool ok = (step >= 0) && (step <= 128) && (n > 0 || ki >= 128);
                    s[i][e] = ok ? s[i][e] : NEG; m = fmaxf(m, s[i][e]); }
            m = fmaxf(m, __shfl_xor(m, 16)); m = fmaxf(m, __shfl_xor(m, 32));
            float lsum = 0.f;
#pragma unroll
            for (int i = 0; i < 9; ++i)
#pragma unroll
                for (int e = 0; e < 4; ++e) { s[i][e] = __builtin_amdgcn_exp2f(s[i][e] - m); lsum += s[i][e]; }
            lsum += __shfl_xor(lsum, 16); lsum += __shfl_xor(lsum, 32);
            f32x4 o[8];
#pragma unroll
            for (int i = 0; i < 8; ++i) o[i] = (f32x4){0.f, 0.f, 0.f, 0.f};
            const unsigned vb = ldsb + (unsigned)(VOFF + (4 * fq + (j >> 2)) * VP + (j & 3) * 8);
#pragma unroll
            for (int k2 = 0; k2 < 5; ++k2) { const int i0 = 2 * k2, i1 = (k2 < 4) ? 2 * k2 + 1 : 8;
                u32x4 pw; pw.x = cvt_pk_bf16(s[i0][0], s[i0][1]); pw.y = cvt_pk_bf16(s[i0][2], s[i0][3]);
                if (k2 < 4) { pw.z = cvt_pk_bf16(s[i1][0], s[i1][1]); pw.w = cvt_pk_bf16(s[i1][2], s[i1][3]); } else { pw.z = 0u; pw.w = 0u; }
                const bf16x8 pb = __builtin_bit_cast(bf16x8, pw);
                const unsigned alo = vb + (unsigned)(16 * ((w + i0) ^ f8) * VP), ahi = vb + (unsigned)(16 * ((w + i1) ^ f8) * VP);
                s16x4 lo[4], hi[4];
                tr8(alo, ahi, lo, hi);
#pragma unroll
                for (int c = 0; c < 4; ++c) o[c] = MFMA16(cat4(lo[c], hi[c]), pb, o[c]);
                tr8(alo + 128, ahi + 128, lo, hi);
#pragma unroll
                for (int c = 0; c < 4; ++c) o[4 + c] = MFMA16(cat4(lo[c], hi[c]), pb, o[4 + c]); }
            const float l0 = m + __builtin_amdgcn_logf(lsum);
            LAS unsigned char* ost = lds + LDS_MAIN + w * 2048;
            if (!stage) {
                const float inv = 1.0f / lsum;
                if (fq == 0) lse[((size_t)pbr * T_TOK + tok0 + ((size_t)j << dsh)) * 16 + h] = l0;
#pragma unroll
                for (int hh = 0; hh < 2; ++hh) {
#pragma unroll
                    for (int c = 0; c < 4; ++c) { const int cc = 4 * hh + c; u32x2 ov; ov.x = cvt_pk_bf16(o[cc][0] * inv, o[cc][1] * inv); ov.y = cvt_pk_bf16(o[cc][2] * inv, o[cc][3] * inv); *(LAS u32x2*)(ost + j * 128 + c * 32 + fq * 8) = ov; }
                    asm volatile("s_waitcnt lgkmcnt(0)" ::: "memory");
                    bf16_t* op = part_o + ((size_t)pbr * T_TOK + tok0) * DM + h * 128 + hh * 64 + rc * 8;
#pragma unroll
                    for (int it = 0; it < 2; ++it) { const int q = 8 * it + rq; *(u32x4*)(op + ((size_t)q << dsh) * DM) = *(const LAS u32x4*)(ost + q * 128 + rc * 16); }
                    asm volatile("s_waitcnt lgkmcnt(0)" ::: "memory");
                }
            } else {
                const float l1 = pl1, l2 = pl2;
                const float mx = fmaxf(l0, fmaxf(l1, l2));
                const float w0 = __builtin_amdgcn_exp2f(l0 - mx), w1 = __builtin_amdgcn_exp2f(l1 - mx), w2 = __builtin_amdgcn_exp2f(l2 - mx);
                const float inv = 1.0f / (w0 + w1 + w2); const float a0 = w0 * inv / lsum;
                LAS float* wst = (LAS float*)(lds + LDS_MAIN + 16384 + w * 128);
                if (fq == 0) { wst[2 * j] = w1 * inv; wst[2 * j + 1] = w2 * inv; }
#pragma unroll
                for (int hh = 0; hh < 2; ++hh) {
#pragma unroll
                    for (int c = 0; c < 4; ++c) { const int cc = 4 * hh + c; u32x2 ov; ov.x = cvt_pk_bf16(o[cc][0] * a0, o[cc][1] * a0); ov.y = cvt_pk_bf16(o[cc][2] * a0, o[cc][3] * a0); *(LAS u32x2*)(ost + j * 128 + c * 32 + fq * 8) = ov; }
                    asm volatile("s_waitcnt lgkmcnt(0)" ::: "memory");
                    bf16_t* op = mo + tok0 * DM + h * 128 + hh * 64 + rc * 8;
#pragma unroll
                    for (int it = 0; it < 2; ++it) { const int q = 8 * it + rq; const u32x4 x0 = *(const LAS u32x4*)(ost + q * 128 + rc * 16);
                        const u32x4 x1 = px1[hh][it], x2 = px2[hh][it]; const float a1 = wst[2 * q], a2 = wst[2 * q + 1];
                        u32x4 ov; ov.x = cvt_pk_bf16(bf_lo(x0.x) + a1 * bf_lo(x1.x) + a2 * bf_lo(x2.x), bf_hi(x0.x) + a1 * bf_hi(x1.x) + a2 * bf_hi(x2.x));
                        ov.y = cvt_pk_bf16(bf_lo(x0.y) + a1 * bf_lo(x1.y) + a2 * bf_lo(x2.y), bf_hi(x0.y) + a1 * bf_hi(x1.y) + a2 * bf_hi(x2.y));
                        ov.z = cvt_pk_bf16(bf_lo(x0.z) + a1 * bf_lo(x1.z) + a2 * bf_lo(x2.z), bf_hi(x0.z) + a1 * bf_hi(x1.z) + a2 * bf_hi(x2.z));
                        ov.w = cvt_pk_bf16(bf_lo(x0.w) + a1 * bf_lo(x1.w) + a2 * bf_lo(x2.w), bf_hi(x0.w) + a1 * bf_hi(x1.w) + a2 * bf_hi(x2.w));
                        *(u32x4*)(op + (size_t)q * DM) = ov; }
                    asm volatile("s_waitcnt lgkmcnt(0)" ::: "memory");
                }
            }
            __syncthreads();
            if (t < 7) { ATT_STORE((t + 1) & 1);
#pragma unroll
                for (int ks = 0; ks < 4; ++ks) qf[ks] = qn[ks]; }
            __syncthreads();
        }
#undef ATT_LOAD
#undef ATT_QLOAD
#undef ATT_STORE
    }
}

__global__ void __launch_bounds__(512) hybrid_trunk_fwd(Params p) {
    extern __shared__ __attribute__((aligned(16))) unsigned char smem[];
    cg::grid_group grid = cg::this_grid();
    LAS unsigned char* lds = (LAS unsigned char*)smem;
    const unsigned ldsb = (unsigned)(uintptr_t)smem;
    unsigned char* ws = p.ws;
    bf16_t* Wt_in = (bf16_t*)(ws + OFF_WIN); bf16_t* Wt_out = (bf16_t*)(ws + OFF_WOUT); bf16_t* Wt_qkv = (bf16_t*)(ws + OFF_WQKV); bf16_t* Wt_o = (bf16_t*)(ws + OFF_WO);
    bf16_t* Wt_up = (bf16_t*)(ws + OFF_WUP); bf16_t* Wt_down = (bf16_t*)(ws + OFF_WDOWN); bf16_t* Wsp = (bf16_t*)(ws + OFF_WSP);
    float* cosT = (float*)(ws + OFF_ROPE); float* sinT = cosT + 4096 * 64; float* stats = (float*)(ws + OFF_STATS); float* lse = (float*)(ws + OFF_LSE);
    bf16_t* hn = (bf16_t*)(ws + OFF_HN); bf16_t* gout = (bf16_t*)(ws + OFF_GOUT); bf16_t* mo = (bf16_t*)(ws + OFF_MO); bf16_t* big = (bf16_t*)(ws + OFF_BIG);
    bf16_t* part_o = (bf16_t*)(ws + OFF_GOUT);
    float* h = p.out;
    float* rbuf = (float*)(ws + OFF_RB);
    const int gtid = blockIdx.x * 512 + threadIdx.x, gsz = gridDim.x * 512;
    volatile LAS unsigned* xst = (volatile LAS unsigned*)(lds + LDS_XB);
    if (threadIdx.x == 0) { xst[0] = 0u; xst[1] = 0u; }
    __syncthreads();
    const XcdBarrier xb = xcd_barrier_post((unsigned*)(ws + OFF_BAR), xst);

    grid.sync();
    {
    transpose_cvt(lds, p.w_in, Wt_in, 2, 2048, 5120, 2);
    transpose_cvt(lds, p.w_out, Wt_out, 2, 2048, 2048, 0);
    transpose_cvt(lds, p.w_qkv, Wt_qkv, 2, 2048, 6144, 1);
    transpose_cvt(lds, p.w_o, Wt_o, 2, 2048, 2048, 0);
    transpose_cvt(lds, p.w_up, Wt_up, 4, 2048, 8192, 0);
    transpose_cvt(lds, p.w_down, Wt_down, 4, 8192, 2048, 0);
    for (int i = gtid; i < 4096 * 64; i += gsz) { const int pos = i >> 6, k = i & 63;
        const float inv_freq = powf(10000.0f, -(float)k * (2.0f / 128.0f)); const float ang = (float)pos * inv_freq;
        cosT[i] = cosf(ang); sinT[i] = sinf(ang); }
    for (int i = gtid; i < 2 * 8 * 128 * 128; i += gsz) { const int s = i & 127, t = (i >> 7) & 127;
        const float v = (s <= t) ? p.w_sp[i] : 0.f; const unsigned pk = cvt_pk_bf16(v, v); Wsp[i] = (bf16_t)(pk & 0xffffu); }
    init_phase(p.x, rbuf, p.n_mix_pre, hn);
    }
    GSYNC();

    for (int layer = 0; layer < 4; ++layer) {
        const int e = layer >> 1;
        pg8::StaticOrder S;
        if ((layer & 1) == 0) {
            { pg8::Gemm g{hn, Wt_in + (size_t)e * 5120 * 2048, T_TOK, 5120, 2048}; S.init(T_TOK, 5120, (int)gridDim.x, (int)blockIdx.x);
              pg8::EpiProj E{big, stats}; pg8::gemm_phase<pg8::EpiProj, pg8::StaticOrder>(lds, g, S, E, nullptr); }
            GSYNC();
            mixer_phase(lds, ldsb, big, stats, Wsp + (size_t)e * 8 * 128 * 128, p.b_sp + (size_t)e * 8 * 128, p.conv_w + (size_t)e * 3 * 1024, mo);
            GSYNC();
        } else {
            { pg8::Gemm g{hn, Wt_qkv + (size_t)e * 6144 * 2048, T_TOK, 6144, 2048}; S.init(T_TOK, 6144, (int)gridDim.x, (int)blockIdx.x);
              pg8::EpiQKV E{big, cosT, sinT}; pg8::gemm_phase<pg8::EpiQKV, pg8::StaticOrder>(lds, g, S, E, nullptr); }
            GSYNC();
            attn_phase(lds, ldsb, big, part_o, lse, mo, 0);
            GSYNC();
            attn_phase(lds, ldsb, big, part_o, lse, mo, 1);
            GSYNC();
        }
        const bf16_t* wt2 = ((layer & 1) == 0) ? (Wt_out + (size_t)e * 2048 * 2048) : (Wt_o + (size_t)e * 2048 * 2048);
            { pg8::Gemm g{mo, wt2, T_TOK, 2048, 2048}; S.init(T_TOK, 2048, (int)gridDim.x, (int)blockIdx.x);
              pg8::EpiBf16 E{gout, DM}; pg8::gemm_phase<pg8::EpiBf16, pg8::StaticOrder>(lds, g, S, E, nullptr); }
            GSYNC();
            norm_phase_b(gout, hn, rbuf, h, p.n_mix_pre + layer * DM, p.n_mix_post + layer * DM, p.n_mlp_pre + layer * DM, 1);
            GSYNC();
        { pg8::Gemm g{hn, Wt_up + (size_t)layer * 8192 * 2048, T_TOK, 8192, 2048}; S.init(T_TOK, 8192, (int)gridDim.x, (int)blockIdx.x);
          pg8::EpiRelu2 E{big, 8192}; pg8::gemm_phase<pg8::EpiRelu2, pg8::StaticOrder>(lds, g, S, E, nullptr); }
        GSYNC();
            { pg8::Gemm g{big, Wt_down + (size_t)layer * 2048 * 8192, T_TOK, 2048, 8192}; S.init(T_TOK, 2048, (int)gridDim.x, (int)blockIdx.x);
              pg8::EpiBf16 E{gout, DM}; pg8::gemm_phase<pg8::EpiBf16, pg8::StaticOrder>(lds, g, S, E, nullptr); }
            GSYNC();
            norm_phase_b(gout, hn, rbuf, h, p.n_mlp_pre + layer * DM, p.n_mlp_post + layer * DM, p.n_mix_pre + (layer < 3 ? layer + 1 : 0) * DM, layer < 3 ? 1 : 2);
            if (layer < 3) GSYNC();
    }
}

extern "C" void kernel_launch(void* const* d_in, const int* in_sizes, int n_in, void* d_out, int out_size, void* d_ws, size_t ws_size, hipStream_t stream) {
    static int grid_blocks = 0;
    if (grid_blocks == 0) {
        if (n_in != 14 || out_size != T_TOK * DM || ws_size < WS_END) { fprintf(stderr, "kernel_launch: unexpected shapes (n_in %d out %d ws %zu need %zu)\n", n_in, out_size, ws_size, (size_t)WS_END); grid_blocks = -1; return; }
        int dev = 0, cus = 0, per_cu = 0;
        (void)hipGetDevice(&dev); (void)hipDeviceGetAttribute(&cus, hipDeviceAttributeMultiprocessorCount, dev);
        if (hipFuncSetAttribute((const void*)hybrid_trunk_fwd, hipFuncAttributeMaxDynamicSharedMemorySize, LDS_BYTES) != hipSuccess) { fprintf(stderr, "kernel_launch: hipFuncSetAttribute failed\n"); grid_blocks = -1; return; }
        if (hipOccupancyMaxActiveBlocksPerMultiprocessor(&per_cu, (const void*)hybrid_trunk_fwd, 512, LDS_BYTES) != hipSuccess || per_cu < 1) { (void)hipGetLastError(); per_cu = 1; }
        if (per_cu > 1) per_cu = 1;
        grid_blocks = cus * per_cu;
    }
    if (grid_blocks < 0) return;
    Params p{};
    p.x = (const float*)d_in[0]; p.n_mix_pre = (const float*)d_in[1]; p.n_mix_post = (const float*)d_in[2]; p.n_mlp_pre = (const float*)d_in[3]; p.n_mlp_post = (const float*)d_in[4];
    p.w_in = (const float*)d_in[5]; p.w_sp = (const float*)d_in[6]; p.b_sp = (const float*)d_in[7]; p.conv_w = (const float*)d_in[8]; p.w_out = (const float*)d_in[9];
    p.w_qkv = (const float*)d_in[10]; p.w_o = (const float*)d_in[11]; p.w_up = (const float*)d_in[12]; p.w_down = (const float*)d_in[13];
    p.out = (float*)d_out; p.ws = (unsigned char*)d_ws;
    if (hipMemsetAsync((unsigned char*)d_ws + OFF_BAR, 0, BAR_BYTES, stream) != hipSuccess) { fprintf(stderr, "kernel_launch: memset of barrier words failed\n"); return; }
    void* args[] = {&p};
    hipError_t e = hipLaunchCooperativeKernel((const void*)hybrid_trunk_fwd, dim3(grid_blocks), dim3(512), args, LDS_BYTES, stream);
    if (e != hipSuccess) fprintf(stderr, "cooperative launch failed: %s (grid %d)\n", hipGetErrorString(e), grid_blocks);
}
```

```cpp
#include <hip/hip_runtime.h>
#include <hip/hip_cooperative_groups.h>
#include <cstdio>
#include <cstdint>
namespace cg = cooperative_groups;

#define PG8_LAS __attribute__((address_space(3)))
#define LAS __attribute__((address_space(3)))
typedef unsigned short bf16_t;
typedef short bf16x8 __attribute__((ext_vector_type(8)));
typedef short s16x4 __attribute__((ext_vector_type(4)));
typedef float f32x4 __attribute__((ext_vector_type(4)));
typedef float f32x2 __attribute__((ext_vector_type(2)));
typedef unsigned u32x4 __attribute__((ext_vector_type(4)));
typedef unsigned u32x2 __attribute__((ext_vector_type(2)));

constexpr int T_TOK = 16384, DM = 2048, SEQ = 4096;

__device__ __forceinline__ unsigned cvt_pk_bf16(float lo, float hi) { unsigned r; asm volatile("v_cvt_pk_bf16_f32 %0, %1, %2" : "=v"(r) : "v"(lo), "v"(hi)); return r; }
__device__ __forceinline__ float bf_lo(unsigned w) { return __uint_as_float(w << 16); }
__device__ __forceinline__ float bf_hi(unsigned w) { return __uint_as_float(w & 0xffff0000u); }
__device__ __forceinline__ float gelu_tanh(float x) {
    const float u = 0.7978845608028654f * (x + 0.044715f * x * x * x);
    const float e = __builtin_amdgcn_exp2f(-2.885390081777927f * u);
    return x * __builtin_amdgcn_rcpf(1.0f + e);
}

namespace pg8 {
constexpr int BM = 256, BK = 64, HALF = 128, HTB = HALF * BK * 2  , STAGE_BYTES = 8 * HTB, NXCD = 8, WGM = 8;

__host__ __device__ __forceinline__ int lds_byte(int r, int c) { const int st = (r >> 4) * 2 + (c >> 5), rr = r & 15, cc = c & 31, ob = rr * 64 + cc * 2; return st * 1024 + (ob ^ (((ob >> 9) & 1) << 5)); }
__host__ __device__ __forceinline__ void stage_rc(int b, int& R, int& C) { const int st = b / 1024, sb = b % 1024, swz = sb ^ (((sb >> 9) & 1) << 5); R = (st >> 1) * 16 + swz / 64; C = (st & 1) * 32 + (swz % 64) / 2; }
__host__ __device__ __forceinline__ int perm32(int rho) { const int n = rho >> 4, i = rho & 15; return 8 * (i >> 2) + 4 * n + (i & 3); }

struct Unit { int pm, pn; };
struct Gemm { const bf16_t* A; const bf16_t* Bt; int M, N, K; };

struct StaticOrder {
    int nM, nN, nwg, G, c;
    __host__ __device__ void init(int M, int N, int G_, int c_) { nM = M / BM; nN = N / BM; nwg = nM * nN; G = G_; c = c_; }
    __host__ __device__ bool next(int i, Unit& u) const {
        const long L = (long)i * G + c; if (L >= nwg) return false;
        int wgid = (int)L; { const int q = nwg / NXCD, r = nwg % NXCD, xcd = wgid % NXCD, off = wgid / NXCD; wgid = (xcd < r ? xcd * (q + 1) : r * (q + 1) + (xcd - r) * q) + off; }
        const int nig = WGM * nN, gid = wgid / nig, fm = gid * WGM, gsz = (nM - fm) < WGM ? (nM - fm) : WGM;
        u.pm = fm + ((wgid % nig) % gsz); u.pn = (wgid % nig) / gsz; return true;
    }
    __device__ __forceinline__ void a_ready(const Unit&) const {}
    __device__ __forceinline__ void done(const Unit&) const {}
};
struct EpiBf16 {
    static constexpr bool PERM = true, AFTER_DRAIN = false;
    bf16_t* O; int ldc;
    __device__ __forceinline__ void operator()(const f32x4 (&acc)[2][2][4][2], const Unit& u, int wr, int wc, int fr, int fq) const {
        const int row0 = u.pm * BM + wr * 64 + fr, col0 = u.pn * BM + wc * 32 + 8 * fq;
#pragma unroll
        for (int ai = 0; ai < 2; ++ai)
#pragma unroll
            for (int m = 0; m < 4; ++m) { bf16_t* rowp = O + (size_t)(row0 + ai * HALF + m * 16) * ldc + col0;
#pragma unroll
                for (int bj = 0; bj < 2; ++bj) { const f32x4 v0 = acc[ai][bj][m][0], v1 = acc[ai][bj][m][1];
                    u32x4 w; w.x = cvt_pk_bf16(v0[0], v0[1]); w.y = cvt_pk_bf16(v0[2], v0[3]); w.z = cvt_pk_bf16(v1[0], v1[1]); w.w = cvt_pk_bf16(v1[2], v1[3]);
                    *(u32x4*)(rowp + bj * HALF) = w; } }
    }
};
struct EpiProj {
    static constexpr bool PERM = true, AFTER_DRAIN = false;
    bf16_t* O; float* stats;
    __device__ __forceinline__ void operator()(const f32x4 (&acc)[2][2][4][2], const Unit& u, int wr, int wc, int fr, int fq) const {
        const int row0 = u.pm * BM + wr * 64 + fr, col0 = u.pn * BM + wc * 32 + 8 * fq;
        const bool act = u.pn < 8, st = (u.pn >= 4) && (u.pn < 8);
        if (u.pn >= 12) {
            const int zc = 3072 + (u.pn - 12) * 128 + wc * 32 + 8 * fq;
#pragma unroll
            for (int ai = 0; ai < 2; ++ai)
#pragma unroll
                for (int m = 0; m < 4; ++m) { const f32x4 z0 = acc[ai][0][m][0] * acc[ai][1][m][0], z1 = acc[ai][0][m][1] * acc[ai][1][m][1];
                    u32x4 w; w.x = cvt_pk_bf16(z0[0], z0[1]); w.y = cvt_pk_bf16(z0[2], z0[3]); w.z = cvt_pk_bf16(z1[0], z1[1]); w.w = cvt_pk_bf16(z1[2], z1[3]);
                    *(u32x4*)(O + (size_t)(row0 + ai * HALF + m * 16) * 5120 + zc) = w; }
            return;
        }
#pragma unroll
        for (int ai = 0; ai < 2; ++ai)
#pragma unroll
            for (int m = 0; m < 4; ++m) { const int row = row0 + ai * HALF + m * 16; bf16_t* rowp = O + (size_t)row * 5120 + col0; float s = 0.f, ss = 0.f;
#pragma unroll
                for (int bj = 0; bj < 2; ++bj) { f32x4 v0 = acc[ai][bj][m][0], v1 = acc[ai][bj][m][1];
                    if (act) {
#pragma unroll
                        for (int j = 0; j < 4; ++j) { v0[j] = gelu_tanh(v0[j]); v1[j] = gelu_tanh(v1[j]); }
                    }
                    u32x4 w; w.x = cvt_pk_bf16(v0[0], v0[1]); w.y = cvt_pk_bf16(v0[2], v0[3]); w.z = cvt_pk_bf16(v1[0], v1[1]); w.w = cvt_pk_bf16(v1[2], v1[3]);
                    if (st) {
                        const float a0 = bf_lo(w.x), a1 = bf_hi(w.x), a2 = bf_lo(w.y), a3 = bf_hi(w.y), a4 = bf_lo(w.z), a5 = bf_hi(w.z), a6 = bf_lo(w.w), a7 = bf_hi(w.w);
                        s += ((a0 + a1) + (a2 + a3)) + ((a4 + a5) + (a6 + a7));
                        ss += ((a0 * a0 + a1 * a1) + (a2 * a2 + a3 * a3)) + ((a4 * a4 + a5 * a5) + (a6 * a6 + a7 * a7)); }
                    *(u32x4*)(rowp + bj * HALF) = w; }
                if (st) { s += __shfl_xor(s, 16); s += __shfl_xor(s, 32); ss += __shfl_xor(ss, 16); ss += __shfl_xor(ss, 32);
                    if (fq == 0) *(f32x2*)(stats + ((size_t)row * 16 + (u.pn - 4) * 4 + wc) * 2) = (f32x2){s, ss}; } }
    }
};
struct EpiRelu2 {
    static constexpr bool PERM = true, AFTER_DRAIN = false;
    bf16_t* O; int ldc;
    __device__ __forceinline__ void operator()(const f32x4 (&acc)[2][2][4][2], const Unit& u, int wr, int wc, int fr, int fq) const {
        const int row0 = u.pm * BM + wr * 64 + fr, col0 = u.pn * BM + wc * 32 + 8 * fq;
#pragma unroll
        for (int ai = 0; ai < 2; ++ai)
#pragma unroll
            for (int m = 0; m < 4; ++m) { bf16_t* rowp = O + (size_t)(row0 + ai * HALF + m * 16) * ldc + col0;
#pragma unroll
                for (int bj = 0; bj < 2; ++bj) { f32x4 v0 = acc[ai][bj][m][0], v1 = acc[ai][bj][m][1];
#pragma unroll
                    for (int j = 0; j < 4; ++j) { const float a = fmaxf(v0[j], 0.f), b = fmaxf(v1[j], 0.f); v0[j] = a * a; v1[j] = b * b; }
                    u32x4 w; w.x = cvt_pk_bf16(v0[0], v0[1]); w.y = cvt_pk_bf16(v0[2], v0[3]); w.z = cvt_pk_bf16(v1[0], v1[1]); w.w = cvt_pk_bf16(v1[2], v1[3]);
                    *(u32x4*)(rowp + bj * HALF) = w; } }
    }
};
struct EpiQKV {
    static constexpr bool PERM = true, AFTER_DRAIN = false;
    bf16_t* O; const float* cosT; const float* sinT;
    __device__ __forceinline__ void operator()(const f32x4 (&acc)[2][2][4][2], const Unit& u, int wr, int wc, int fr, int fq) const {
        const int row0 = u.pm * BM + wr * 64 + fr, dlo = (wc & 1) * 32 + 8 * fq, head = (u.pn & 7) * 2 + (wc >> 1);
        const bool rot = u.pn < 16; const float qs = (u.pn < 8) ? (0.08838834764831845f * 1.4426950408889634f) : 1.0f;
        bf16_t* base = O + (size_t)(u.pn >> 3) * ((size_t)T_TOK * DM) + (size_t)head * (SEQ * 128) + dlo;
#pragma unroll
        for (int ai = 0; ai < 2; ++ai)
#pragma unroll
            for (int m = 0; m < 4; ++m) { const int row = row0 + ai * HALF + m * 16, pos = row & (SEQ - 1);
                bf16_t* rowp = base + (size_t)(row >> 12) * (16 * SEQ * 128) + (size_t)pos * 128;
                f32x4 x1a = acc[ai][0][m][0], x1b = acc[ai][0][m][1], x2a = acc[ai][1][m][0], x2b = acc[ai][1][m][1];
                if (rot) { const float* cp = cosT + pos * 64 + dlo; const float* sp = sinT + pos * 64 + dlo;
                    const f32x4 ca = *(const f32x4*)cp, cb = *(const f32x4*)(cp + 4), sa = *(const f32x4*)sp, sb = *(const f32x4*)(sp + 4);
                    const f32x4 o1a = (x1a * ca - x2a * sa) * qs, o1b = (x1b * cb - x2b * sb) * qs, o2a = (x2a * ca + x1a * sa) * qs, o2b = (x2b * cb + x1b * sb) * qs;
                    x1a = o1a; x1b = o1b; x2a = o2a; x2b = o2b; }
                u32x4 w1, w2; w1.x = cvt_pk_bf16(x1a[0], x1a[1]); w1.y = cvt_pk_bf16(x1a[2], x1a[3]); w1.z = cvt_pk_bf16(x1b[0], x1b[1]); w1.w = cvt_pk_bf16(x1b[2], x1b[3]);
                w2.x = cvt_pk_bf16(x2a[0], x2a[1]); w2.y = cvt_pk_bf16(x2a[2], x2a[3]); w2.z = cvt_pk_bf16(x2b[0], x2b[1]); w2.w = cvt_pk_bf16(x2b[2], x2b[3]);
                *(u32x4*)rowp = w1; *(u32x4*)(rowp + 64) = w2; }
    }
};

template <class Epi, class Sched, bool STAMP = false>
__device__ __forceinline__ void gemm_phase(PG8_LAS unsigned char* lds, const Gemm g, const Sched& S, const Epi& E, unsigned long long* stamps) {
    int tid = threadIdx.x; asm volatile("" : "+v"(tid));
    const int wid = __builtin_amdgcn_readfirstlane(tid >> 6), lane = tid & 63, wr = wid >> 2, wc = wid & 3, fr = lane & 15, fq = lane >> 4;
    const int K = g.K, nt = K / BK;
    int ts_lo = 0, ts_hi = 0, nts = 0; const unsigned long long rt_entry = STAMP ? (unsigned long long)wall_clock64() : 0ull;
#define PG8_STAMP() do { if (STAMP && wid == 0 && nts < 64) { const unsigned long long _c = (unsigned long long)clock64(); \
        ts_lo = (lane == nts) ? (int)(unsigned)_c : ts_lo; ts_hi = (lane == nts) ? (int)(unsigned)(_c >> 32) : ts_hi; ++nts; } } while (0)
    PG8_STAMP();
    unsigned voffA[2], voffB[2];
#pragma unroll
    for (int i = 0; i < 2; ++i) { int R, C; stage_rc(tid * 16 + i * 8192, R, C); const int Rb = Epi::PERM ? ((R & ~31) + perm32(R & 31)) : R;
        voffA[i] = (unsigned)(R * K + C) * 2u; voffB[i] = (unsigned)(Rb * K + C) * 2u; }
    const size_t kstep = (size_t)(BK * 2);
    const size_t hstep = (size_t)HALF * K * 2;
    const size_t tstep = 2 * hstep;
    const unsigned ldsw = (unsigned)wid * 1024u;
    const int aoff = lds_byte(wr * 64 + fr, fq * 8), boff = lds_byte(wc * 32 + fr, fq * 8);
#define PG8_SA(b, h) (((b) * 2 + (h)) * HTB)
#define PG8_SB(b, h) ((4 + (b) * 2 + (h)) * HTB)
#define PG8_STAGE(bufoff, gbase, voff) do { _Pragma("unroll") for (int _i = 0; _i < 2; ++_i) \
        __builtin_amdgcn_global_load_lds((const unsigned*)((const char*)(gbase) + (voff)[_i]), (PG8_LAS unsigned*)(lds + (bufoff) + ldsw + _i * 8192), 16, 0, 0); } while (0)
#define PG8_LDA(dst, b, h) do { _Pragma("unroll") for (int m = 0; m < 4; ++m) _Pragma("unroll") for (int k = 0; k < 2; ++k) dst[m][k] = *(const PG8_LAS bf16x8*)(lds + PG8_SA(b, h) + aoff + m * 2048 + k * 1024); } while (0)
#define PG8_LDB(dst, b, h) do { _Pragma("unroll") for (int n = 0; n < 2; ++n) _Pragma("unroll") for (int k = 0; k < 2; ++k) dst[n][k] = *(const PG8_LAS bf16x8*)(lds + PG8_SB(b, h) + boff + n * 2048 + k * 1024); } while (0)
#define PG8_MMA(ai, bj, At, Bt) do { __builtin_amdgcn_s_setprio(1); _Pragma("unroll") for (int m = 0; m < 4; ++m) _Pragma("unroll") for (int n = 0; n < 2; ++n) _Pragma("unroll") for (int k = 0; k < 2; ++k) \
        acc[ai][bj][m][n] = __builtin_amdgcn_mfma_f32_16x16x32_bf16(Bt[n][k], At[m][k], acc[ai][bj][m][n], 0, 0, 0); __builtin_amdgcn_s_setprio(0); } while (0)
#define PG8_WAIT_V(n) asm volatile("s_waitcnt vmcnt(" #n ")" ::: "memory")
#define PG8_WAIT_L(n) asm volatile("s_waitcnt lgkmcnt(" #n ")" ::: "memory")
#define PG8_BAR __builtin_amdgcn_s_barrier()
#define PG8_SCHED __builtin_amdgcn_sched_barrier(0)
    Unit cur, nxt; int ui = 0;
    if (!S.next(0, cur)) return;
    f32x4 acc[2][2][4][2];
#pragma unroll
    for (int a = 0; a < 2; ++a)
#pragma unroll
        for (int b = 0; b < 2; ++b)
#pragma unroll
            for (int m = 0; m < 4; ++m)
#pragma unroll
                for (int n = 0; n < 2; ++n) acc[a][b][m][n] = (f32x4){0.f, 0.f, 0.f, 0.f};
    bf16x8 At[4][2], B0[2][2], B1[2][2];
    const char* cA = (const char*)g.A + (size_t)cur.pm * tstep; const char* cB = (const char*)g.Bt + (size_t)cur.pn * tstep;
    S.a_ready(cur);
    PG8_STAGE(PG8_SB(0, 0), cB, voffB); PG8_STAGE(PG8_SA(0, 0), cA, voffA); PG8_STAGE(PG8_SB(0, 1), cB + hstep, voffB); PG8_STAGE(PG8_SA(0, 1), cA + hstep, voffA);
    if (wr == 1) PG8_BAR;
    PG8_WAIT_V(4); PG8_BAR;
    PG8_STAGE(PG8_SB(1, 0), cB + kstep, voffB); PG8_STAGE(PG8_SA(1, 0), cA + kstep, voffA); PG8_STAGE(PG8_SB(1, 1), cB + hstep + kstep, voffB);
    PG8_WAIT_V(6); PG8_BAR;
    PG8_STAMP();
    for (;;) {
        const bool has_next = S.next(ui + 1, nxt);
        const char* nA = has_next ? (const char*)g.A + (size_t)nxt.pm * tstep : cA; const char* nB = has_next ? (const char*)g.Bt + (size_t)nxt.pn * tstep : cB;
        for (int t = 0; t < nt; t += 2) {
            const bool last = (t == nt - 2);
            const char* a1 = cA + (size_t)(t + 1) * kstep;
            const char* a2 = last ? nA : cA + (size_t)(t + 2) * kstep; const char* b2 = last ? nB : cB + (size_t)(t + 2) * kstep;
            const char* a3 = a2 + kstep; const char* b3 = b2 + kstep;
            if (last && has_next) S.a_ready(nxt);
            PG8_LDB(B0, 0, 0); PG8_SCHED; PG8_LDA(At, 0, 0); PG8_STAGE(PG8_SA(1, 1), a1 + hstep, voffA);
            PG8_WAIT_L(8); PG8_BAR; PG8_WAIT_L(0); PG8_MMA(0, 0, At, B0); PG8_BAR; PG8_SCHED;
            PG8_LDB(B1, 0, 1); PG8_STAGE(PG8_SB(0, 0), b2, voffB);
            PG8_BAR; PG8_WAIT_L(0); PG8_MMA(0, 1, At, B1); PG8_BAR;
            PG8_LDA(At, 0, 1); PG8_STAGE(PG8_SA(0, 0), a2, voffA);
            PG8_BAR; PG8_WAIT_L(0); PG8_MMA(1, 0, At, B0); PG8_BAR; PG8_SCHED;
            PG8_STAGE(PG8_SB(0, 1), b2 + hstep, voffB);
            PG8_WAIT_V(6); PG8_BAR; PG8_MMA(1, 1, At, B1); PG8_BAR;
            PG8_LDB(B0, 1, 0); PG8_SCHED; PG8_LDA(At, 1, 0); PG8_STAGE(PG8_SA(0, 1), a2 + hstep, voffA);
            PG8_WAIT_L(8); PG8_BAR; PG8_WAIT_L(0); PG8_MMA(0, 0, At, B0); PG8_BAR; PG8_SCHED;
            PG8_LDB(B1, 1, 1); PG8_STAGE(PG8_SB(1, 0), b3, voffB);
            PG8_BAR; PG8_WAIT_L(0); PG8_MMA(0, 1, At, B1); PG8_BAR;
            PG8_LDA(At, 1, 1); PG8_STAGE(PG8_SA(1, 0), a3, voffA);
            PG8_BAR; PG8_WAIT_L(0); PG8_MMA(1, 0, At, B0); PG8_BAR; PG8_SCHED;
            PG8_STAGE(PG8_SB(1, 1), b3 + hstep, voffB);
            PG8_WAIT_V(6); PG8_BAR; PG8_MMA(1, 1, At, B1); PG8_BAR;
        }
        PG8_STAMP();
        if constexpr (!Epi::AFTER_DRAIN) { E(acc, cur, wr, wc, fr, fq); S.done(cur); }
        PG8_STAMP();
        if (!has_next) break;
#pragma unroll
        for (int a = 0; a < 2; ++a)
#pragma unroll
            for (int b = 0; b < 2; ++b)
#pragma unroll
                for (int m = 0; m < 4; ++m)
#pragma unroll
                    for (int n = 0; n < 2; ++n) acc[a][b][m][n] = (f32x4){0.f, 0.f, 0.f, 0.f};
        cur = nxt; cA = nA; cB = nB; ++ui;
    }
    PG8_WAIT_V(0);
    if (wr == 0) PG8_BAR;
    PG8_BAR;
    if constexpr (Epi::AFTER_DRAIN) { E.fused(acc, cur, wr, wc, fr, fq, lds, wid, lane); S.done(cur); }
    PG8_STAMP();
    if (STAMP && wid == 0) { stamps[lane] = lane < nts ? (((unsigned long long)(unsigned)ts_hi << 32) | (unsigned)ts_lo) : 0ull;
        if (lane == 62) stamps[62] = rt_entry; if (lane == 63) stamps[63] = (unsigned long long)wall_clock64(); }
#undef PG8_STAMP
#undef PG8_SA
#undef PG8_SB
#undef PG8_STAGE
#undef PG8_LDA
#undef PG8_LDB
#undef PG8_MMA
#undef PG8_WAIT_V
#undef PG8_WAIT_L
#undef PG8_BAR
#undef PG8_SCHED
}}

#define XB_TMO      128
#define XB_XCNT(j)  (256  + 64 * (j))
#define XB_XSUB(j)  (1280 + 64 * (j))
#define XB_XGEN(j)  (2304 + 64 * (j))
#define XB_TOP      3328
#define XB_TOPGEN   3392
#define XCD_BAR_WORDS 3456
#define XB_SPIN_CAP (1u << 22)

__device__ __forceinline__ unsigned xb_ld(unsigned* p)              { return __hip_atomic_load(p, __ATOMIC_RELAXED, __HIP_MEMORY_SCOPE_AGENT); }
__device__ __forceinline__ unsigned xb_add(unsigned* p, unsigned v) { return __hip_atomic_fetch_add(p, v, __ATOMIC_RELAXED, __HIP_MEMORY_SCOPE_AGENT); }
__device__ __forceinline__ unsigned xb_xcc_id() { return (unsigned)__builtin_amdgcn_s_getreg((3 << 11) | 20) & 0xFu; }
#define XB_SPIN(cond, bar) do { unsigned _sp = 0; while (cond) { __builtin_amdgcn_s_sleep(1); \
    if ((++_sp & 255u) == 0u) { if (xb_ld(&(bar)[XB_TMO])) break; if (_sp > XB_SPIN_CAP) { atomicAdd(&(bar)[XB_TMO], 1u); break; } } } } while (0)

struct XcdBarrier {
    unsigned* bar; unsigned x;
    volatile LAS unsigned* st;
};

__device__ __forceinline__ XcdBarrier xcd_barrier_post(unsigned* bar, volatile LAS unsigned* st) {
    XcdBarrier b; b.bar = bar; b.x = xb_xcc_id(); b.st = st;
    if (threadIdx.x == 0) (void)xb_add(&bar[XB_XCNT(b.x)], 1u);
    return b;
}
__device__ __forceinline__ void xcd_barrier_complete(unsigned* bar, unsigned x, unsigned& nloc, unsigned& nx) {
    const unsigned G = gridDim.x * gridDim.y * gridDim.z;
    unsigned sum, cnt, mine, sp = 0u;
    for (;;) {
        sum = 0u; cnt = 0u; mine = 0u;
#pragma unroll
        for (unsigned j = 0; j < 16; ++j) { const unsigned c = xb_ld(&bar[XB_XCNT(j)]); sum += c; cnt += (c > 0u) ? 1u : 0u; mine = (j == x) ? c : mine; }
        if (sum == G) break;
        __builtin_amdgcn_s_sleep(1);
        if ((++sp & 255u) == 0u) { if (xb_ld(&bar[XB_TMO])) break; if (sp > XB_SPIN_CAP) { atomicAdd(&bar[XB_TMO], 1u); break; } }
    }
    nloc = mine > 0u ? mine : 1u; nx = cnt > 0u ? cnt : 1u;
}

__device__ __forceinline__ void xcd_barrier(const XcdBarrier& b) {
    asm volatile("s_waitcnt vmcnt(0)" ::: "memory");
    __syncthreads();
    if (threadIdx.x == 0) {
        unsigned* bar = b.bar;
        __builtin_amdgcn_s_waitcnt(0);
        unsigned nloc = b.st[0], nx = b.st[1];
        if (nloc == 0u) { xcd_barrier_complete(bar, b.x, nloc, nx); b.st[0] = nloc; b.st[1] = nx; }
        const unsigned old = xb_add(&bar[XB_XSUB(b.x)], 1u);
        const unsigned gen = old / nloc;
        if (old + 1u == (gen + 1u) * nloc) {
            __builtin_amdgcn_fence(__ATOMIC_RELEASE, "agent");
            asm volatile("s_waitcnt vmcnt(0)" ::: "memory");
            const unsigned og = xb_add(&bar[XB_TOP], 1u);
            const unsigned tg = og / nx;
            if (og + 1u == (tg + 1u) * nx) xb_add(&bar[XB_TOPGEN], 1u);
            else XB_SPIN(xb_ld(&bar[XB_TOPGEN]) == tg, bar);
            __builtin_amdgcn_fence(__ATOMIC_ACQUIRE, "agent");
            xb_add(&bar[XB_XGEN(b.x)], 1u);
            asm volatile("s_waitcnt vmcnt(0)" ::: "memory");
        } else {
            XB_SPIN(xb_ld(&bar[XB_XGEN(b.x)]) == gen, bar);
            __builtin_amdgcn_fence(__ATOMIC_ACQUIRE, "agent");
            asm volatile("s_waitcnt vmcnt(0)" ::: "memory");
        }
    }
    __syncthreads();
}

constexpr size_t SZ_WIN = (size_t)2 * 5120 * 2048 * 2, SZ_W22 = (size_t)2 * 2048 * 2048 * 2, SZ_WQKV = (size_t)2 * 6144 * 2048 * 2, SZ_WUP = (size_t)4 * 8192 * 2048 * 2;
constexpr size_t OFF_WIN = 0, OFF_WOUT = OFF_WIN + SZ_WIN, OFF_WQKV = OFF_WOUT + SZ_W22, OFF_WO = OFF_WQKV + SZ_WQKV, OFF_WUP = OFF_WO + SZ_W22, OFF_WDOWN = OFF_WUP + SZ_WUP;
constexpr size_t OFF_WSP = OFF_WDOWN + SZ_WUP;
constexpr size_t OFF_ROPE = OFF_WSP + (size_t)2 * 8 * 128 * 128 * 2;
constexpr size_t OFF_STATS = OFF_ROPE + (size_t)2 * 4096 * 64 * 4;
constexpr size_t OFF_LSE = OFF_STATS + (size_t)T_TOK * 16 * 8;
constexpr size_t OFF_HN = OFF_LSE + (size_t)3 * T_TOK * 16 * 4;
constexpr size_t OFF_GOUT = OFF_HN + (size_t)T_TOK * DM * 2;
constexpr size_t OFF_MO = OFF_GOUT + (size_t)T_TOK * DM * 4;
constexpr size_t OFF_BIG = OFF_MO + (size_t)T_TOK * DM * 2;
constexpr size_t OFF_BAR = OFF_BIG + (size_t)T_TOK * 8192 * 2;
constexpr size_t BAR_BYTES = 16384;
constexpr size_t OFF_RB = OFF_BAR + BAR_BYTES;
constexpr size_t WS_END = OFF_RB + (size_t)T_TOK * 4;
constexpr int LDS_MAIN = 143360;
constexpr int LDS_XB = LDS_MAIN + 16384 + 1024;
constexpr int LDS_BYTES = LDS_XB + 16;
#define GSYNC() xcd_barrier(xb)

struct Params {
    const float* x; const float* n_mix_pre; const float* n_mix_post; const float* n_mlp_pre; const float* n_mlp_post;
    const float* w_in; const float* w_sp; const float* b_sp; const float* conv_w; const float* w_out; const float* w_qkv; const float* w_o; const float* w_up; const float* w_down;
    float* out; unsigned char* ws;
};

__device__ __forceinline__ void transpose_cvt(LAS unsigned char* lds, const float* __restrict__ W, bf16_t* __restrict__ Wt, int L, int K, int N, int perm) {
    int tid = threadIdx.x; asm volatile("" : "+v"(tid));
    const int tk = K >> 7, tn = N >> 6, per = tk * tn, ntile = L * per;
    const int kp0 = tid >> 4, c4 = tid & 15;
    f32x4 ra[2], rb[2];
#define TR_LOAD(t_) do { const int l_ = (t_) / per, r_ = (t_) - l_ * per, kt_ = r_ / tn, nt_ = r_ - kt_ * tn; const float* src_ = W + ((size_t)l_ * K + (size_t)kt_ * 128) * N + nt_ * 64 + 4 * c4; \
        _Pragma("unroll") for (int i_ = 0; i_ < 2; ++i_) { const int kp_ = kp0 + 32 * i_; ra[i_] = *(const f32x4*)(src_ + (size_t)(2 * kp_) * N); rb[i_] = *(const f32x4*)(src_ + (size_t)(2 * kp_ + 1) * N); } } while (0)
    int t = blockIdx.x;
    if (t < ntile) TR_LOAD(t);
    for (; t < ntile; t += gridDim.x) {
        const int l = t / per, r = t - l * per, kt = r / tn, nt = r - kt * tn;
        __syncthreads();
#pragma unroll
        for (int i = 0; i < 2; ++i) { const int kp = kp0 + 32 * i;
#pragma unroll
            for (int j = 0; j < 4; ++j) *(LAS unsigned*)(lds + (4 * c4 + j) * 272 + kp * 4) = cvt_pk_bf16(ra[i][j], rb[i][j]); }
        if (t + (int)gridDim.x < ntile) TR_LOAD(t + (int)gridDim.x);
        __syncthreads();
#pragma unroll
        for (int i = 0; i < 2; ++i) { const int idx = tid + 512 * i, n = idx >> 4, kc = idx & 15;
            const u32x4 v = *(const LAS u32x4*)(lds + n * 272 + kc * 16);
            int ncol = nt * 64 + n;
            if (perm == 1) { const int nl = ncol & 255, hl = nl >> 7, dd = nl & 127; ncol = (ncol & ~255) + (dd >> 6) * 128 + hl * 64 + (dd & 63); }
            if (perm == 2 && ncol >= 3072) { const int q = ncol - 3072, c = q & 1023; ncol = 3072 + (c >> 7) * 256 + (q >> 10) * 128 + (c & 127); }
            *(u32x4*)(Wt + ((size_t)l * N + ncol) * K + kt * 128 + kc * 8) = v; }
    }
#undef TR_LOAD
}

__device__ __forceinline__ void norm_phase_b(const bf16_t* __restrict__ gin, bf16_t* hn, float* rbuf, float* __restrict__ outf, const float* __restrict__ gprev, const float* __restrict__ gpost, const float* __restrict__ gpre, int mode) {
    int tid = threadIdx.x; asm volatile("" : "+v"(tid));
    const int lane = tid & 63, w = tid >> 6;
    for (int row = blockIdx.x * 8 + w; row < T_TOK; row += gridDim.x * 8) {
        f32x4 ha[4], hc[4]; u32x4 gv[4]; bf16_t* hp = hn + (size_t)row * DM + 8 * lane; const bf16_t* gp = gin + (size_t)row * DM + 8 * lane; float ss = 0.f;
        const float rinv = __builtin_amdgcn_rcpf(rbuf[row]);
#pragma unroll
        for (int i = 0; i < 4; ++i) { const u32x4 hw = *(const u32x4*)(hp + 512 * i); gv[i] = *(const u32x4*)(gp + 512 * i);
            const f32x4 pa = *(const f32x4*)(gprev + 8 * lane + 512 * i), pb = *(const f32x4*)(gprev + 8 * lane + 512 * i + 4);
            ha[i] = ((f32x4){bf_lo(hw.x), bf_hi(hw.x), bf_lo(hw.y), bf_hi(hw.y)} * rinv) * (f32x4){__builtin_amdgcn_rcpf(pa[0]), __builtin_amdgcn_rcpf(pa[1]), __builtin_amdgcn_rcpf(pa[2]), __builtin_amdgcn_rcpf(pa[3])};
            hc[i] = ((f32x4){bf_lo(hw.z), bf_hi(hw.z), bf_lo(hw.w), bf_hi(hw.w)} * rinv) * (f32x4){__builtin_amdgcn_rcpf(pb[0]), __builtin_amdgcn_rcpf(pb[1]), __builtin_amdgcn_rcpf(pb[2]), __builtin_amdgcn_rcpf(pb[3])};
            const float a0 = bf_lo(gv[i].x), a1 = bf_hi(gv[i].x), a2 = bf_lo(gv[i].y), a3 = bf_hi(gv[i].y), a4 = bf_lo(gv[i].z), a5 = bf_hi(gv[i].z), a6 = bf_lo(gv[i].w), a7 = bf_hi(gv[i].w);
            ss += ((a0 * a0 + a1 * a1) + (a2 * a2 + a3 * a3)) + ((a4 * a4 + a5 * a5) + (a6 * a6 + a7 * a7)); }
#pragma unroll
        for (int o = 1; o < 64; o <<= 1) ss += __shfl_xor(ss, o);
        const float r = 1.0f / sqrtf(ss * (1.0f / DM) + 1e-6f);
        float ss2 = 0.f;
#pragma unroll
        for (int i = 0; i < 4; ++i) { const f32x4 ga = *(const f32x4*)(gpost + 8 * lane + 512 * i), gb = *(const f32x4*)(gpost + 8 * lane + 512 * i + 4);
            const f32x4 xa = (f32x4){bf_lo(gv[i].x), bf_hi(gv[i].x), bf_lo(gv[i].y), bf_hi(gv[i].y)}, xb = (f32x4){bf_lo(gv[i].z), bf_hi(gv[i].z), bf_lo(gv[i].w), bf_hi(gv[i].w)};
            ha[i] = ha[i] + (xa * r) * ga; hc[i] = hc[i] + (xb * r) * gb;
            ss2 += ((ha[i][0] * ha[i][0] + ha[i][1] * ha[i][1]) + (ha[i][2] * ha[i][2] + ha[i][3] * ha[i][3])) + ((hc[i][0] * hc[i][0] + hc[i][1] * hc[i][1]) + (hc[i][2] * hc[i][2] + hc[i][3] * hc[i][3])); }
        if (mode == 2) { float* op = outf + (size_t)row * DM + 8 * lane;
#pragma unroll
            for (int i = 0; i < 4; ++i) { *(f32x4*)(op + 512 * i) = ha[i]; *(f32x4*)(op + 512 * i + 4) = hc[i]; }
        } else {
#pragma unroll
            for (int o = 1; o < 64; o <<= 1) ss2 += __shfl_xor(ss2, o);
            const float r2 = 1.0f / sqrtf(ss2 * (1.0f / DM) + 1e-6f);
            if (lane == 0) rbuf[row] = r2;
#pragma unroll
            for (int i = 0; i < 4; ++i) { const f32x4 ga = *(const f32x4*)(gpre + 8 * lane + 512 * i), gb = *(const f32x4*)(gpre + 8 * lane + 512 * i + 4);
                const f32x4 ya = (ha[i] * r2) * ga, yb = (hc[i] * r2) * gb;
                u32x4 wv; wv.x = cvt_pk_bf16(ya[0], ya[1]); wv.y = cvt_pk_bf16(ya[2], ya[3]); wv.z = cvt_pk_bf16(yb[0], yb[1]); wv.w = cvt_pk_bf16(yb[2], yb[3]); *(u32x4*)(hp + 512 * i) = wv; }
        }
    }
}

__device__ __forceinline__ void init_phase(const float* __restrict__ x, float* __restrict__ rbuf, const float* __restrict__ gpre, bf16_t* __restrict__ hn) {
    int tid = threadIdx.x; asm volatile("" : "+v"(tid));
    const int lane = tid & 63, w = tid >> 6;
    for (int row = blockIdx.x * 8 + w; row < T_TOK; row += gridDim.x * 8) {
        f32x4 ha[4], hc[4]; const float* hp = x + (size_t)row * DM + 8 * lane; float ss = 0.f;
#pragma unroll
        for (int i = 0; i < 4; ++i) { ha[i] = *(const f32x4*)(hp + 512 * i); hc[i] = *(const f32x4*)(hp + 512 * i + 4);
            ss += ((ha[i][0] * ha[i][0] + ha[i][1] * ha[i][1]) + (ha[i][2] * ha[i][2] + ha[i][3] * ha[i][3])) + ((hc[i][0] * hc[i][0] + hc[i][1] * hc[i][1]) + (hc[i][2] * hc[i][2] + hc[i][3] * hc[i][3])); }
#pragma unroll
        for (int o = 1; o < 64; o <<= 1) ss += __shfl_xor(ss, o);
        const float r = 1.0f / sqrtf(ss * (1.0f / DM) + 1e-6f);
        if (lane == 0) rbuf[row] = r;
        bf16_t* np = hn + (size_t)row * DM + 8 * lane;
#pragma unroll
        for (int i = 0; i < 4; ++i) { const f32x4 ga = *(const f32x4*)(gpre + 8 * lane + 512 * i), gb = *(const f32x4*)(gpre + 8 * lane + 512 * i + 4);
            const f32x4 ya = (ha[i] * r) * ga, yb = (hc[i] * r) * gb;
            u32x4 wv; wv.x = cvt_pk_bf16(ya[0], ya[1]); wv.y = cvt_pk_bf16(ya[2], ya[3]); wv.z = cvt_pk_bf16(yb[0], yb[1]); wv.w = cvt_pk_bf16(yb[2], yb[3]); *(u32x4*)(np + 512 * i) = wv; }
    }
}

__device__ __forceinline__ void tr8(unsigned alo, unsigned ahi, s16x4 (&lo)[4], s16x4 (&hi)[4]) {
    asm volatile("ds_read_b64_tr_b16 %0, %8\n\tds_read_b64_tr_b16 %1, %8 offset:32\n\tds_read_b64_tr_b16 %2, %8 offset:64\n\tds_read_b64_tr_b16 %3, %8 offset:96\n\t"
                 "ds_read_b64_tr_b16 %4, %9\n\tds_read_b64_tr_b16 %5, %9 offset:32\n\tds_read_b64_tr_b16 %6, %9 offset:64\n\tds_read_b64_tr_b16 %7, %9 offset:96\n\t"
                 "s_waitcnt lgkmcnt(0)"
                 : "=&v"(lo[0]), "=&v"(lo[1]), "=&v"(lo[2]), "=&v"(lo[3]), "=&v"(hi[0]), "=&v"(hi[1]), "=&v"(hi[2]), "=&v"(hi[3]) : "v"(alo), "v"(ahi) : "memory");
}
__device__ __forceinline__ bf16x8 cat4(s16x4 a, s16x4 b) { return (bf16x8){a[0], a[1], a[2], a[3], b[0], b[1], b[2], b[3]}; }
#define MFMA16(a, b, c) __builtin_amdgcn_mfma_f32_16x16x32_bf16((a), (b), (c), 0, 0, 0)

__device__ __forceinline__ void mixer_phase(LAS unsigned char* lds, unsigned ldsb, const bf16_t* __restrict__ proj, const float* __restrict__ stats, const bf16_t* __restrict__ Wc,
                                            const float* __restrict__ b_s, const float* __restrict__ conv_w, bf16_t* __restrict__ mo) {
    constexpr int VP = 288;
    int tid = threadIdx.x; asm volatile("" : "+v"(tid));
    const int w = __builtin_amdgcn_readfirstlane(tid >> 6), lane = tid & 63, j = lane & 15, fq = lane >> 4;
    LAS float* mu_s = (LAS float*)(lds + 128 * VP); LAS float* rs_s = mu_s + 128;
    const bool xdeal = (gridDim.x == 256);
    int last_ch = -1;
    for (int it0 = blockIdx.x, ii = 0; it0 < 1024; it0 += gridDim.x, ++ii) {
        const int item = xdeal ? (128 * ((int)blockIdx.x & 7) + 4 * ((int)blockIdx.x >> 3) + ii) : it0;
        const int ch = item >> 3, g = item & 7, tok0 = ch * 128;
        u32x4 cgb[4], cz0[4], cz1[4], cz2[4];
#pragma unroll
        for (int i = 0; i < 4; ++i) { const int c = tid + 512 * i, row = c >> 4, ck = c & 15, cB = g * 128 + ck * 8, tok = tok0 + row, pos = tok & (SEQ - 1);
            const bf16_t* pp = proj + (size_t)tok * 5120 + cB;
            cgb[i] = *(const u32x4*)(pp + 2048); cz0[i] = *(const u32x4*)(pp + 3072);
            cz1[i] = (u32x4){0, 0, 0, 0}; cz2[i] = cz1[i];
            if (pos >= 1) cz1[i] = *(const u32x4*)(pp - 5120 + 3072);
            if (pos >= 2) cz2[i] = *(const u32x4*)(pp - 10240 + 3072); }
        __syncthreads();
        if (ch != last_ch) {
        last_ch = ch;
        if (tid < 128) { const f32x2* sp = (const f32x2*)(stats + (size_t)(tok0 + tid) * 32); float s = 0.f, ss = 0.f;
#pragma unroll
            for (int i = 0; i < 16; ++i) { const f32x2 v = sp[i]; s += v.x; ss += v.y; }
            const float mu = s * (1.0f / 1024.0f), var = fmaxf(ss * (1.0f / 1024.0f) - mu * mu, 0.f);
            mu_s[tid] = mu; rs_s[tid] = 1.0f / sqrtf(var + 1e-5f); }
        __syncthreads();
        }
#pragma unroll
        for (int i = 0; i < 4; ++i) { const int c = tid + 512 * i, row = c >> 4, ck = c & 15;
            const u32x4 raw = *(const u32x4*)(proj + (size_t)(tok0 + row) * 5120 + 1024 + g * 128 + ck * 8);
            const float mu = mu_s[row], rs = rs_s[row]; u32x4 o;
            o.x = cvt_pk_bf16((bf_lo(raw.x) - mu) * rs, (bf_hi(raw.x) - mu) * rs); o.y = cvt_pk_bf16((bf_lo(raw.y) - mu) * rs, (bf_hi(raw.y) - mu) * rs);
            o.z = cvt_pk_bf16((bf_lo(raw.z) - mu) * rs, (bf_hi(raw.z) - mu) * rs); o.w = cvt_pk_bf16((bf_lo(raw.w) - mu) * rs, (bf_hi(raw.w) - mu) * rs);
            *(LAS u32x4*)(lds + row * VP + ck * 16) = o; }
        __syncthreads();
        const int t = 16 * w + j;
        const bf16_t* wp = Wc + (size_t)(g * 128 + t) * 128 + 4 * fq;
        const float bias = b_s[g * 128 + t];
        u32x2 aup[8];
        { const bf16_t* up = proj + (size_t)(tok0 + t) * 5120 + g * 128 + 4 * fq;
#pragma unroll
          for (int c = 0; c < 8; ++c) aup[c] = *(const u32x2*)(up + 16 * c); }
        f32x4 acc[8];
#pragma unroll
        for (int i = 0; i < 8; ++i) acc[i] = (f32x4){0.f, 0.f, 0.f, 0.f};
        const unsigned abase = ldsb + (unsigned)((4 * fq + (j >> 2)) * VP + (j & 3) * 8);
#pragma unroll
        for (int ks = 0; ks < 4; ++ks) {
            if (ks <= (w >> 1)) {
                const s16x4 b0 = *(const s16x4*)(wp + 32 * ks), b1 = *(const s16x4*)(wp + 32 * ks + 16);
                const bf16x8 b = cat4(b0, b1);
                s16x4 lo[4], hi[4];
                const unsigned alo = abase + (unsigned)(32 * ks * VP), ahi = alo + 16 * VP;
                tr8(alo, ahi, lo, hi);
#pragma unroll
                for (int c = 0; c < 4; ++c) acc[c] = MFMA16(cat4(lo[c], hi[c]), b, acc[c]);
                tr8(alo + 128, ahi + 128, lo, hi);
#pragma unroll
                for (int c = 0; c < 4; ++c) acc[4 + c] = MFMA16(cat4(lo[c], hi[c]), b, acc[4 + c]);
            }
        }
        {
            bf16_t* op = mo + (size_t)(tok0 + t) * DM + g * 128 + 4 * fq;
#pragma unroll
            for (int c = 0; c < 8; ++c) { const u32x2 au = aup[c]; u32x2 o;
                o.x = cvt_pk_bf16(bf_lo(au.x) * (acc[c][0] + bias), bf_hi(au.x) * (acc[c][1] + bias));
                o.y = cvt_pk_bf16(bf_lo(au.y) * (acc[c][2] + bias), bf_hi(au.y) * (acc[c][3] + bias));
                *(u32x2*)(op + 16 * c) = o; }
        }
#pragma unroll
        for (int i = 0; i < 4; ++i) { const int c = tid + 512 * i, row = c >> 4, ck = c & 15, cB = g * 128 + ck * 8, tok = tok0 + row;
            const u32x4 gb = cgb[i], z0 = cz0[i], z1 = cz1[i], z2 = cz2[i];
            const f32x4 w0a = *(const f32x4*)(conv_w + cB), w0b = *(const f32x4*)(conv_w + cB + 4);
            const f32x4 w1a = *(const f32x4*)(conv_w + 1024 + cB), w1b = *(const f32x4*)(conv_w + 1024 + cB + 4);
            const f32x4 w2a = *(const f32x4*)(conv_w + 2048 + cB), w2b = *(const f32x4*)(conv_w + 2048 + cB + 4);
            const unsigned gbw[4] = {gb.x, gb.y, gb.z, gb.w}, z0w[4] = {z0.x, z0.y, z0.z, z0.w}, z1w[4] = {z1.x, z1.y, z1.z, z1.w}, z2w[4] = {z2.x, z2.y, z2.z, z2.w};
            const float wt0[8] = {w0a[0], w0a[1], w0a[2], w0a[3], w0b[0], w0b[1], w0b[2], w0b[3]}, wt1[8] = {w1a[0], w1a[1], w1a[2], w1a[3], w1b[0], w1b[1], w1b[2], w1b[3]},
                        wt2[8] = {w2a[0], w2a[1], w2a[2], w2a[3], w2b[0], w2b[1], w2b[2], w2b[3]};
            unsigned ow[4];
#pragma unroll
            for (int q = 0; q < 4; ++q) {
                const float ylo = wt0[2 * q] * bf_lo(z2w[q]) + wt1[2 * q] * bf_lo(z1w[q]) + wt2[2 * q] * bf_lo(z0w[q]);
                const float yhi = wt0[2 * q + 1] * bf_hi(z2w[q]) + wt1[2 * q + 1] * bf_hi(z1w[q]) + wt2[2 * q + 1] * bf_hi(z0w[q]);
                ow[q] = cvt_pk_bf16(bf_lo(gbw[q]) * ylo, bf_hi(gbw[q]) * yhi); }
            *(u32x4*)(mo + (size_t)tok * DM + 1024 + cB) = (u32x4){ow[0], ow[1], ow[2], ow[3]}; }
    }
}

__device__ __forceinline__ void attn_phase(LAS unsigned char* lds, unsigned ldsb, const bf16_t* __restrict__ qkv, bf16_t* __restrict__ part_o, float* __restrict__ lse, bf16_t* __restrict__ mo, const int stage) {
    constexpr int KP = 272, VP = 288, VOFF = 256 * KP;
    int tid = threadIdx.x; asm volatile("" : "+v"(tid));
    const int w = __builtin_amdgcn_readfirstlane(tid >> 6), lane = tid & 63, j = lane & 15, fq = lane >> 4;
    __syncthreads();
    for (int o = tid * 16; o < LDS_MAIN; o += 512 * 16) *(LAS u32x4*)(lds + o) = (u32x4){0u, 0u, 0u, 0u};
    const int nitems = stage ? 256 : 512;
    const int srow = tid >> 4, sck = tid & 15;
    for (int item = blockIdx.x; item < nitems; item += gridDim.x) {
        const int h = (item >> 2) & 15, b = (item >> 6) & 3, lowq = item & 3;
        int dsh, rbase, nbase, pbr; bool seq2;
        if (stage) { dsh = 0; rbase = 0; nbase = 8 * lowq; seq2 = false; pbr = 0; }
        else if (item < 256) { dsh = 2; rbase = lowq; nbase = 0; seq2 = false; pbr = 0; }
        else { dsh = 4; rbase = 4 * lowq; nbase = 0; seq2 = true; pbr = 1; }
        const bf16_t* qh = qkv + (size_t)(b * 16 + h) * (SEQ * 128);
        u32x4 kreg[4], vreg[4];
#define ATT_LOAD(r_, n_) do { _Pragma("unroll") for (int i_ = 0; i_ < 4; ++i_) { const bf16_t* p_ = qh + (size_t)((r_) + ((128 * (n_) + srow + 32 * i_) << dsh)) * 128 + sck * 8; \
            kreg[i_] = *(const u32x4*)(p_ + (size_t)T_TOK * DM); vreg[i_] = *(const u32x4*)(p_ + (size_t)2 * T_TOK * DM); } } while (0)
#define ATT_STORE(slot_) do { _Pragma("unroll") for (int i_ = 0; i_ < 4; ++i_) { const int row_ = (slot_) * 128 + srow + 32 * i_; \
            *(LAS u32x4*)(lds + row_ * KP + sck * 16) = kreg[i_]; *(LAS u32x4*)(lds + VOFF + row_ * VP + sck * 16) = vreg[i_]; } } while (0)
        __syncthreads();
        bf16x8 qf[4], qn[4];
#define ATT_QLOAD(dst_, r_, n_) do { const bf16_t* qp_ = qh + (size_t)((r_) + ((128 * (n_) + 16 * w + j) << dsh)) * 128 + 8 * fq; \
            _Pragma("unroll") for (int ks_ = 0; ks_ < 4; ++ks_) dst_[ks_] = *(const bf16x8*)(qp_ + 32 * ks_); } while (0)
        { if (stage && nbase > 0) { ATT_LOAD(rbase, nbase - 1); ATT_STORE(1); }
          ATT_LOAD(rbase, nbase); ATT_QLOAD(qf, rbase, nbase); ATT_STORE(0); }
        __syncthreads();
        for (int t = 0; t < 8; ++t) {
            const int n = seq2 ? (t & 1) : nbase + t;
            const int rr = rbase + (seq2 ? (t >> 1) : 0);
            if (t < 7) { const int t1 = t + 1; const int n1 = seq2 ? (t1 & 1) : nbase + t1; const int rr1 = rbase + (seq2 ? (t1 >> 1) : 0); ATT_LOAD(rr1, n1); ATT_QLOAD(qn, rr1, n1); }
            const int f8 = (t & 1) ? 0 : 8;
            const int sq0 = rr + ((128 * n + 16 * w) << dsh);
            const size_t tok0 = (size_t)b * SEQ + sq0;
            const int rq = lane >> 3, rc = lane & 7;
            u32x4 px1[2][2], px2[2][2]; float pl1 = 0.f, pl2 = 0.f;
            if (stage) { const bf16_t* p1 = part_o + tok0 * DM + h * 128 + rc * 8; const bf16_t* p2 = p1 + (size_t)T_TOK * DM;
#pragma unroll
                for (int hh = 0; hh < 2; ++hh)
#pragma unroll
                    for (int it = 0; it < 2; ++it) { const int q = 8 * it + rq; px1[hh][it] = *(const u32x4*)(p1 + (size_t)q * DM + hh * 64); px2[hh][it] = *(const u32x4*)(p2 + (size_t)q * DM + hh * 64); }
                pl1 = lse[(tok0 + j) * 16 + h]; pl2 = lse[((size_t)T_TOK + tok0 + j) * 16 + h]; }
            f32x4 s[9];
#pragma unroll
            for (int i = 0; i < 9; ++i) { s[i] = (f32x4){0.f, 0.f, 0.f, 0.f};
                const LAS unsigned char* ka = lds + (16 * ((w + i) ^ f8) + j) * KP + 16 * fq;
#pragma unroll
                for (int ks = 0; ks < 4; ++ks) s[i] = MFMA16(*(const LAS bf16x8*)(ka + 64 * ks), qf[ks], s[i]); }
            const float NEG = -__builtin_inff();
            float m = NEG;
#pragma unroll
            for (int i = 0; i < 9; ++i) { const bool tv = (n > 0) || (w + i >= 8);
#pragma unroll
                for (int e = 0; e < 4; ++e) { bool ok = tv;
                    if (i == 0) ok = ok && (j <= 4 * fq + e);
                    if (i == 8) ok = ok && (j >= 4 * fq + e);
                    s[i][e] = ok ? s[i][e] : NEG; m = fmaxf(m, s[i][e]); } }
            m = fmaxf(m, __shfl_xor(m, 16)); m = fmaxf(m, __shfl_xor(m, 32));
            float lsum = 0.f;
#pragma unroll
            for (int i = 0; i < 9; ++i)
#pragma unroll
                for (int e = 0; e < 4; ++e) { s[i][e] = __builtin_amdgcn_exp2f(s[i][e] - m); lsum += s[i][e]; }
            lsum += __shfl_xor(lsum, 16); lsum += __shfl_xor(lsum, 32);
            f32x4 o[8];
#pragma unroll
            for (int i = 0; i < 8; ++i) o[i] = (f32x4){0.f, 0.f, 0.f, 0.f};
            const unsigned vb = ldsb + (unsigned)(VOFF + (4 * fq + (j >> 2)) * VP + (j & 3) * 8);
#pragma unroll
            for (int k2 = 0; k2 < 5; ++k2) { const int i0 = 2 * k2, i1 = (k2 < 4) ? 2 * k2 + 1 : 8;
                u32x4 pw; pw.x = cvt_pk_bf16(s[i0][0], s[i0][1]); pw.y = cvt_pk_bf16(s[i0][2], s[i0][3]);
                if (k2 < 4) { pw.z = cvt_pk_bf16(s[i1][0], s[i1][1]); pw.w = cvt_pk_bf16(s[i1][2], s[i1][3]); } else { pw.z = 0u; pw.w = 0u; }
                const bf16x8 pb = __builtin_bit_cast(bf16x8, pw);
                const unsigned alo = vb + (unsigned)(16 * ((w + i0) ^ f8) * VP), ahi = vb + (unsigned)(16 * ((w + i1) ^ f8) * VP);
                s16x4 lo[4], hi[4];
                tr8(alo, ahi, lo, hi);
#pragma unroll
                for (int c = 0; c < 4; ++c) o[c] = MFMA16(cat4(lo[c], hi[c]), pb, o[c]);
                tr8(alo + 128, ahi + 128, lo, hi);
#pragma unroll
                for (int c = 0; c < 4; ++c) o[4 + c] = MFMA16(cat4(lo[c], hi[c]), pb, o[4 + c]); }
            const float l0 = m + __builtin_amdgcn_logf(lsum);
            LAS unsigned char* ost = lds + LDS_MAIN + w * 2048;
            if (!stage) {
                const float inv = 1.0f / lsum;
                if (fq == 0) lse[((size_t)pbr * T_TOK + tok0 + ((size_t)j << dsh)) * 16 + h] = l0;
#pragma unroll
                for (int hh = 0; hh < 2; ++hh) {
#pragma unroll
                    for (int c = 0; c < 4; ++c) { const int cc = 4 * hh + c; u32x2 ov; ov.x = cvt_pk_bf16(o[cc][0] * inv, o[cc][1] * inv); ov.y = cvt_pk_bf16(o[cc][2] * inv, o[cc][3] * inv); *(LAS u32x2*)(ost + j * 128 + c * 32 + fq * 8) = ov; }
                    asm volatile("s_waitcnt lgkmcnt(0)" ::: "memory");
                    bf16_t* op = part_o + ((size_t)pbr * T_TOK + tok0) * DM + h * 128 + hh * 64 + rc * 8;
#pragma unroll
                    for (int it = 0; it < 2; ++it) { const int q = 8 * it + rq; *(u32x4*)(op + ((size_t)q << dsh) * DM) = *(const LAS u32x4*)(ost + q * 128 + rc * 16); }
                    asm volatile("s_waitcnt lgkmcnt(0)" ::: "memory");
                }
            } else {
                const float l1 = pl1, l2 = pl2;
                const float mx = fmaxf(l0, fmaxf(l1, l2));
                const float w0 = __builtin_amdgcn_exp2f(l0 - mx), w1 = __builtin_amdgcn_exp2f(l1 - mx), w2 = __builtin_amdgcn_exp2f(l2 - mx);
                const float inv = 1.0f / (w0 + w1 + w2); const float a0 = w0 * inv / lsum;
                LAS float* wst = (LAS float*)(lds + LDS_MAIN + 16384 + w * 128);
                if (fq == 0) { wst[2 * j] = w1 * inv; wst[2 * j + 1] = w2 * inv; }
#pragma unroll
                for (int hh = 0; hh < 2; ++hh) {
#pragma unroll
                    for (int c = 0; c < 4; ++c) { const int cc = 4 * hh + c; u32x2 ov; ov.x = cvt_pk_bf16(o[cc][0] * a0, o[cc][1] * a0); ov.y = cvt_pk_bf16(o[cc][2] * a0, o[cc][3] * a0); *(LAS u32x2*)(ost + j * 128 + c * 32 + fq * 8) = ov; }
                    asm volatile("s_waitcnt lgkmcnt(0)" ::: "memory");
                    bf16_t* op = mo + tok0 * DM + h * 128 + hh * 64 + rc * 8;
#pragma unroll
                    for (int it = 0; it < 2; ++it) { const int q = 8 * it + rq; const u32x4 x0 = *(const LAS u32x4*)(ost + q * 128 + rc * 16);
                        const u32x4 x1 = px1[hh][it], x2 = px2[hh][it]; const float a1 = wst[2 * q], a2 = wst[2 * q + 1];
                        u32x4 ov; ov.x = cvt_pk_bf16(bf_lo(x0.x) + a1 * bf_lo(x1.x) + a2 * bf_lo(x2.x), bf_hi(x0.x) + a1 * bf_hi(x1.x) + a2 * bf_hi(x2.x));
                        ov.y = cvt_pk_bf16(bf_lo(x0.y) + a1 * bf_lo(x1.y) + a2 * bf_lo(x2.y), bf_hi(x0.y) + a1 * bf_hi(x1.y) + a2 * bf_hi(x2.y));
                        ov.z = cvt_pk_bf16(bf_lo(x0.z) + a1 * bf_lo(x1.z) + a2 * bf_lo(x2.z), bf_hi(x0.z) + a1 * bf_hi(x1.z) + a2 * bf_hi(x2.z));
                        ov.w = cvt_pk_bf16(bf_lo(x0.w) + a1 * bf_lo(x1.w) + a2 * bf_lo(x2.w), bf_hi(x0.w) + a1 * bf_hi(x1.w) + a2 * bf_hi(x2.w));
                        *(u32x4*)(op + (size_t)q * DM) = ov; }
                    asm volatile("s_waitcnt lgkmcnt(0)" ::: "memory");
                }
            }
            __syncthreads();
            if (t < 7) { ATT_STORE((t + 1) & 1);
#pragma unroll
                for (int ks = 0; ks < 4; ++ks) qf[ks] = qn[ks]; }
            __syncthreads();
        }
#undef ATT_LOAD
#undef ATT_QLOAD
#undef ATT_STORE
    }
}

__global__ void __launch_bounds__(512) hybrid_trunk_fwd(Params p) {
    extern __shared__ __attribute__((aligned(16))) unsigned char smem[];
    cg::grid_group grid = cg::this_grid();
    LAS unsigned char* lds = (LAS unsigned char*)smem;
    const unsigned ldsb = (unsigned)(uintptr_t)smem;
    unsigned char* ws = p.ws;
    bf16_t* Wt_in = (bf16_t*)(ws + OFF_WIN); bf16_t* Wt_out = (bf16_t*)(ws + OFF_WOUT); bf16_t* Wt_qkv = (bf16_t*)(ws + OFF_WQKV); bf16_t* Wt_o = (bf16_t*)(ws + OFF_WO);
    bf16_t* Wt_up = (bf16_t*)(ws + OFF_WUP); bf16_t* Wt_down = (bf16_t*)(ws + OFF_WDOWN); bf16_t* Wsp = (bf16_t*)(ws + OFF_WSP);
    float* cosT = (float*)(ws + OFF_ROPE); float* sinT = cosT + 4096 * 64; float* stats = (float*)(ws + OFF_STATS); float* lse = (float*)(ws + OFF_LSE);
    bf16_t* hn = (bf16_t*)(ws + OFF_HN); bf16_t* gout = (bf16_t*)(ws + OFF_GOUT); bf16_t* mo = (bf16_t*)(ws + OFF_MO); bf16_t* big = (bf16_t*)(ws + OFF_BIG);
    bf16_t* part_o = (bf16_t*)(ws + OFF_GOUT);
    float* h = p.out;
    float* rbuf = (float*)(ws + OFF_RB);
    const int gtid = blockIdx.x * 512 + threadIdx.x, gsz = gridDim.x * 512;
    volatile LAS unsigned* xst = (volatile LAS unsigned*)(lds + LDS_XB);
    if (threadIdx.x == 0) { xst[0] = 0u; xst[1] = 0u; }
    __syncthreads();
    const XcdBarrier xb = xcd_barrier_post((unsigned*)(ws + OFF_BAR), xst);

    grid.sync();
    {
    transpose_cvt(lds, p.w_in, Wt_in, 2, 2048, 5120, 2);
    transpose_cvt(lds, p.w_out, Wt_out, 2, 2048, 2048, 0);
    transpose_cvt(lds, p.w_qkv, Wt_qkv, 2, 2048, 6144, 1);
    transpose_cvt(lds, p.w_o, Wt_o, 2, 2048, 2048, 0);
    transpose_cvt(lds, p.w_up, Wt_up, 4, 2048, 8192, 0);
    transpose_cvt(lds, p.w_down, Wt_down, 4, 8192, 2048, 0);
    for (int i = gtid; i < 4096 * 64; i += gsz) { const int pos = i >> 6, k = i & 63;
        const float inv_freq = powf(10000.0f, -(float)k * (2.0f / 128.0f)); const float ang = (float)pos * inv_freq;
        cosT[i] = cosf(ang); sinT[i] = sinf(ang); }
    for (int i = gtid; i < 2 * 8 * 128 * 128; i += gsz) { const int s = i & 127, t = (i >> 7) & 127;
        const float v = (s <= t) ? p.w_sp[i] : 0.f; const unsigned pk = cvt_pk_bf16(v, v); Wsp[i] = (bf16_t)(pk & 0xffffu); }
    init_phase(p.x, rbuf, p.n_mix_pre, hn);
    }
    GSYNC();

    for (int layer = 0; layer < 4; ++layer) {
        const int e = layer >> 1;
        pg8::StaticOrder S;
        if ((layer & 1) == 0) {
            { pg8::Gemm g{hn, Wt_in + (size_t)e * 5120 * 2048, T_TOK, 5120, 2048}; S.init(T_TOK, 5120, (int)gridDim.x, (int)blockIdx.x);
              pg8::EpiProj E{big, stats}; pg8::gemm_phase<pg8::EpiProj, pg8::StaticOrder>(lds, g, S, E, nullptr); }
            GSYNC();
            mixer_phase(lds, ldsb, big, stats, Wsp + (size_t)e * 8 * 128 * 128, p.b_sp + (size_t)e * 8 * 128, p.conv_w + (size_t)e * 3 * 1024, mo);
            GSYNC();
        } else {
            { pg8::Gemm g{hn, Wt_qkv + (size_t)e * 6144 * 2048, T_TOK, 6144, 2048}; S.init(T_TOK, 6144, (int)gridDim.x, (int)blockIdx.x);
              pg8::EpiQKV E{big, cosT, sinT}; pg8::gemm_phase<pg8::EpiQKV, pg8::StaticOrder>(lds, g, S, E, nullptr); }
            GSYNC();
            attn_phase(lds, ldsb, big, part_o, lse, mo, 0);
            GSYNC();
            attn_phase(lds, ldsb, big, part_o, lse, mo, 1);
            GSYNC();
        }
        const bf16_t* wt2 = ((layer & 1) == 0) ? (Wt_out + (size_t)e * 2048 * 2048) : (Wt_o + (size_t)e * 2048 * 2048);
            { pg8::Gemm g{mo, wt2, T_TOK, 2048, 2048}; S.init(T_TOK, 2048, (int)gridDim.x, (int)blockIdx.x);
              pg8::EpiBf16 E{gout, DM}; pg8::gemm_phase<pg8::EpiBf16, pg8::StaticOrder>(lds, g, S, E, nullptr); }
            GSYNC();
            norm_phase_b(gout, hn, rbuf, h, p.n_mix_pre + layer * DM, p.n_mix_post + layer * DM, p.n_mlp_pre + layer * DM, 1);
            GSYNC();
        { pg8::Gemm g{hn, Wt_up + (size_t)layer * 8192 * 2048, T_TOK, 8192, 2048}; S.init(T_TOK, 8192, (int)gridDim.x, (int)blockIdx.x);
          pg8::EpiRelu2 E{big, 8192}; pg8::gemm_phase<pg8::EpiRelu2, pg8::StaticOrder>(lds, g, S, E, nullptr); }
        GSYNC();
            { pg8::Gemm g{big, Wt_down + (size_t)layer * 2048 * 8192, T_TOK, 2048, 8192}; S.init(T_TOK, 2048, (int)gridDim.x, (int)blockIdx.x);
              pg8::EpiBf16 E{gout, DM}; pg8::gemm_phase<pg8::EpiBf16, pg8::StaticOrder>(lds, g, S, E, nullptr); }
            GSYNC();
            norm_phase_b(gout, hn, rbuf, h, p.n_mlp_pre + layer * DM, p.n_mlp_post + layer * DM, p.n_mix_pre + (layer < 3 ? layer + 1 : 0) * DM, layer < 3 ? 1 : 2);
            if (layer < 3) GSYNC();
    }
}

extern "C" void kernel_launch(void* const* d_in, const int* in_sizes, int n_in, void* d_out, int out_size, void* d_ws, size_t ws_size, hipStream_t stream) {
    static int grid_blocks = 0;
    if (grid_blocks == 0) {
        if (n_in != 14 || out_size != T_TOK * DM || ws_size < WS_END) { fprintf(stderr, "kernel_launch: unexpected shapes (n_in %d out %d ws %zu need %zu)\n", n_in, out_size, ws_size, (size_t)WS_END); grid_blocks = -1; return; }
        int dev = 0, cus = 0, per_cu = 0;
        (void)hipGetDevice(&dev); (void)hipDeviceGetAttribute(&cus, hipDeviceAttributeMultiprocessorCount, dev);
        if (hipFuncSetAttribute((const void*)hybrid_trunk_fwd, hipFuncAttributeMaxDynamicSharedMemorySize, LDS_BYTES) != hipSuccess) { fprintf(stderr, "kernel_launch: hipFuncSetAttribute failed\n"); grid_blocks = -1; return; }
        if (hipOccupancyMaxActiveBlocksPerMultiprocessor(&per_cu, (const void*)hybrid_trunk_fwd, 512, LDS_BYTES) != hipSuccess || per_cu < 1) { (void)hipGetLastError(); per_cu = 1; }
        if (per_cu > 1) per_cu = 1;
        grid_blocks = cus * per_cu;
    }
    if (grid_blocks < 0) return;
    Params p{};
    p.x = (const float*)d_in[0]; p.n_mix_pre = (const float*)d_in[1]; p.n_mix_post = (const float*)d_in[2]; p.n_mlp_pre = (const float*)d_in[3]; p.n_mlp_post = (const float*)d_in[4];
    p.w_in = (const float*)d_in[5]; p.w_sp = (const float*)d_in[6]; p.b_sp = (const float*)d_in[7]; p.conv_w = (const float*)d_in[8]; p.w_out = (const float*)d_in[9];
    p.w_qkv = (const float*)d_in[10]; p.w_o = (const float*)d_in[11]; p.w_up = (const float*)d_in[12]; p.w_down = (const float*)d_in[13];
    p.out = (float*)d_out; p.ws = (unsigned char*)d_ws;
    if (hipMemsetAsync((unsigned char*)d_ws + OFF_BAR, 0, BAR_BYTES, stream) != hipSuccess) { fprintf(stderr, "kernel_launch: memset of barrier words failed\n"); return; }
    void* args[] = {&p};
    hipError_t e = hipLaunchCooperativeKernel((const void*)hybrid_trunk_fwd, dim3(grid_blocks), dim3(512), args, LDS_BYTES, stream);
    if (e != hipSuccess) fprintf(stderr, "cooperative launch failed: %s (grid %d)\n", hipGetErrorString(e), grid_blocks);
}
```
